# Optimizing an MI355X kernel written in HIP

```python
import math
import jax, jax.numpy as jnp
from jax import lax
import numpy as np

D_MODEL = 1024
BATCH = 8
SEQ = 4096
DEPTH = 2

GRID_W = 64
CTX_LEN = 256

SSD_EXPAND = 2
SSD_INNER = SSD_EXPAND * D_MODEL
SSD_HEAD_DIM = 64
SSD_HEADS = SSD_INNER // SSD_HEAD_DIM
SSD_GROUPS = 4
SSD_HPG = SSD_HEADS // SSD_GROUPS
SSD_STATE = 128
SSD_CHUNK = 64
SSD_CONV = 3
XBC_WIDTH = SSD_INNER + 2 * SSD_GROUPS * SSD_STATE

SC_WIDTH = D_MODEL
SC_CONV = 3

N_BRANCH = 2
N_MOD = 6
IN_WIDTH = SSD_INNER + XBC_WIDTH + 2 * SSD_HEADS + 3 * SC_WIDTH + N_BRANCH * D_MODEL

FFN_DENSE = 2816
N_EXPERTS = 8
TOP_K = 2
FFN_EXPERT = 3584
N_DENSE = (DEPTH + 1) // 2
N_MOE = DEPTH // 2

EPS = 1e-6

kernel_name = "hybrid_ssd_shortconv_moe_diffusion_block"


def rmsnorm(x, g):
    xf = x.astype(jnp.float32)
    y = xf * lax.rsqrt(jnp.mean(xf * xf, axis=-1, keepdims=True) + EPS)
    return (y * g.astype(jnp.float32)).astype(x.dtype)


def modulate(h, shift, scale):
    return h * (1.0 + scale) + shift


def dwconv_centred(u, w, axis):
    k = w.shape[0]
    p = k // 2
    n = u.shape[axis]
    pad = [(0, 0)] * u.ndim
    pad[axis] = (p, p)
    up = jnp.pad(u, pad)
    return sum(lax.slice_in_dim(up, j, j + n, axis=axis) * w[j] for j in range(k))


def split_proj(proj):
    offs = np.cumsum([SSD_INNER, XBC_WIDTH, 2 * SSD_HEADS, 3 * SC_WIDTH]).tolist()
    return jnp.split(proj, offs, axis=-1)


def ssd_inputs(xbc, conv_w, conv_b):
    xbc = jax.nn.silu(dwconv_centred(xbc, conv_w, axis=1) + conv_b)
    xs, bm, cm = jnp.split(xbc, [SSD_INNER, SSD_INNER + SSD_GROUPS * SSD_STATE], axis=-1)
    b, n = xs.shape[:2]
    return (xs.reshape(b, n, SSD_HEADS, SSD_HEAD_DIM),
            bm.reshape(b, n, SSD_GROUPS, SSD_STATE),
            cm.reshape(b, n, SSD_GROUPS, SSD_STATE))


def ssd_dt(dt_raw, dt_bias, a_log):
    dt = jax.nn.softplus(dt_raw.astype(jnp.float32) + dt_bias.reshape(-1).astype(jnp.float32))
    a = -jnp.exp(a_log.astype(jnp.float32))
    return dt[..., :SSD_HEADS], dt[..., SSD_HEADS:], a[0], a[1]


def ssd_scan(x, dt, a, bm, cm, s0):
    b, n = x.shape[:2]
    nc = n // SSD_CHUNK
    xc = (x * dt[..., None]).reshape(b, nc, SSD_CHUNK, SSD_GROUPS, SSD_HPG, SSD_HEAD_DIM)
    a_cs = jnp.cumsum((dt * a).reshape(b, nc, SSD_CHUNK, SSD_GROUPS, SSD_HPG), axis=2)
    bc = bm.reshape(b, nc, SSD_CHUNK, SSD_GROUPS, SSD_STATE)
    cc = cm.reshape(b, nc, SSD_CHUNK, SSD_GROUPS, SSD_STATE)
    seg = a_cs[:, :, :, None] - a_cs[:, :, None, :]
    lower = jnp.tril(jnp.ones((SSD_CHUNK, SSD_CHUNK), dtype=bool))[:, :, None, None]
    decay_ls = jnp.exp(jnp.where(lower, seg, -jnp.inf))
    scores = jnp.einsum("bclgn,bcsgn->bclsg", cc, bc)
    y_diag = jnp.einsum("bclsgh,bcsghp->bclghp", scores[..., None] * decay_ls, xc)
    decay_to_end = jnp.exp(a_cs[:, :, -1:] - a_cs)
    chunk_states = jnp.einsum("bclgn,bclghp->bcghpn", bc, xc * decay_to_end[..., None])
    chunk_decay = jnp.exp(a_cs[:, :, -1])

    def step(s, inp):
        st, dec = inp
        return s * dec[..., None, None] + st, s

    s_final, s_enter = lax.scan(step, s0, (jnp.moveaxis(chunk_states, 1, 0),
                                           jnp.moveaxis(chunk_decay, 1, 0)))
    s_enter = jnp.moveaxis(s_enter, 0, 1)
    y_off = jnp.einsum("bclgn,bcghpn->bclghp", cc, s_enter) * jnp.exp(a_cs)[..., None]
    y = (y_diag + y_off).reshape(b, n, SSD_HEADS, SSD_HEAD_DIM)
    return y, s_final


def ssd_final_state(x, dt, a, bm):
    b, n = x.shape[:2]
    a_cs = jnp.cumsum(dt * a, axis=1)
    w = jnp.exp(a_cs[:, -1:] - a_cs) * dt
    xw = (x * w[..., None]).reshape(b, n, SSD_GROUPS, SSD_HPG, SSD_HEAD_DIM)
    return jnp.einsum("blgn,blghp->bghpn", bm, xw)


def flip(t):
    return jnp.flip(t, axis=1)


def short_conv(sc, conv_w, grid_rows):
    gb, gc, hv = jnp.split(sc, 3, axis=-1)
    u = gc * hv
    if grid_rows is None:
        v = dwconv_centred(u, conv_w, axis=1)
    else:
        b, n, ch = u.shape
        v = dwconv_centred(u.reshape(b, grid_rows, GRID_W, ch), conv_w, axis=2).reshape(b, n, ch)
    return gb * v


def token_mixer(h, s0_f, s0_b, grid_rows, w_in, b_gate, conv_w, conv_b, dt_bias, a_log,
                d_skip, ssd_norm_g, w_ssd_out, sc_conv_w, w_sc_out, w_o):
    b, n, _ = h.shape
    z, xbc, dt_raw, sc, gl = split_proj(h @ w_in)
    xs, bm, cm = ssd_inputs(xbc, conv_w, conv_b)
    dt_f, dt_b, a_f, a_b = ssd_dt(dt_raw, dt_bias, a_log)
    y_f, s_f = ssd_scan(xs, dt_f, a_f, bm, cm, s0_f)
    y_b, s_b = ssd_scan(flip(xs), flip(dt_b), a_b, flip(bm), flip(cm), s0_b)
    y = y_f + flip(y_b) + d_skip.astype(jnp.float32)[:, None] * xs.astype(jnp.float32)
    y = y.reshape(b, n, SSD_INNER) * jax.nn.silu(z.astype(jnp.float32))
    y_ssd = rmsnorm(y, ssd_norm_g).astype(h.dtype) @ w_ssd_out
    y_sc = short_conv(sc, sc_conv_w, grid_rows) @ w_sc_out
    g = jax.nn.sigmoid((gl + b_gate).astype(jnp.float32)).reshape(b, n, N_BRANCH, D_MODEL).astype(h.dtype)
    out = (g[:, :, 0] * y_ssd + g[:, :, 1] * y_sc) @ w_o
    return out, s_f, s_b


def context_states(hc, w_in, conv_w, conv_b, dt_bias, a_log):
    cols = hc @ w_in[:, SSD_INNER:SSD_INNER + XBC_WIDTH + 2 * SSD_HEADS]
    xbc, dt_raw = jnp.split(cols, [XBC_WIDTH], axis=-1)
    xs, bm, _ = ssd_inputs(xbc, conv_w, conv_b)
    dt_f, dt_b, a_f, a_b = ssd_dt(dt_raw, dt_bias, a_log)
    s_f = ssd_final_state(xs, dt_f, a_f, bm)
    s_b = ssd_final_state(flip(xs), flip(dt_b), a_b, flip(bm))
    return s_f, s_b


def swiglu(h, w1, w3, w2):
    return (jax.nn.silu(h @ w1) * (h @ w3)) @ w2


def moe_swiglu(h, router_w, w1, w3, w2):
    shp = h.shape
    t = h.reshape(-1, shp[-1])
    logits = (t @ router_w).astype(jnp.float32)
    top_v, top_i = lax.top_k(logits, TOP_K)
    top_w = jax.nn.softmax(top_v, axis=-1)
    gates = jnp.sum(jax.nn.one_hot(top_i, N_EXPERTS, dtype=jnp.float32) * top_w[..., None], axis=1)
    out = jnp.zeros_like(t)
    for e in range(N_EXPERTS):
        out = out + gates[:, e:e + 1].astype(t.dtype) * swiglu(t, w1[e], w3[e], w2[e])
    return out.reshape(shp)


def channel_mixer(h, i, ffn_w1, ffn_w3, ffn_w2, router_w, moe_w1, moe_w3, moe_w2):
    j = i // 2
    if i % 2 == 0:
        return swiglu(h, ffn_w1[j], ffn_w3[j], ffn_w2[j])
    return moe_swiglu(h, router_w[j], moe_w1[j], moe_w3[j], moe_w2[j])


def setup_inputs(seed: int = 0) -> dict:
    key = jax.random.key(seed)
    ks = iter(jax.random.split(key, 40))
    D = D_MODEL

    def nrm(shape, scale):
        return jax.random.normal(next(ks), shape, jnp.float32) * scale

    dt0 = jnp.exp(jax.random.uniform(next(ks), (DEPTH, 2, SSD_HEADS), jnp.float32,
                                     minval=math.log(1e-3), maxval=math.log(1e-1)))
    dt_bias = dt0 + jnp.log(-jnp.expm1(-dt0))
    a_log = jnp.log(jax.random.uniform(next(ks), (DEPTH, 2, SSD_HEADS), jnp.float32, minval=1.0, maxval=16.0))
    return {
        "x": nrm((BATCH, SEQ, D), 1.0),
        "c": nrm((BATCH, D), 1.0),
        "ctx": nrm((BATCH, CTX_LEN, D), 1.0),
        "c_ctx": nrm((D,), 1.0),
        "w_mod": nrm((DEPTH, D, N_MOD * D), 0.5 * D ** -0.5),
        "b_mod": nrm((DEPTH, N_MOD * D), 0.02),
        "norm1_g": 1.0 + nrm((DEPTH, D), 0.1),
        "norm2_g": 1.0 + nrm((DEPTH, D), 0.1),
        "w_in": nrm((DEPTH, D, IN_WIDTH), D ** -0.5),
        "b_gate": nrm((DEPTH, N_BRANCH * D), 0.1),
        "ssd_conv_w": nrm((DEPTH, SSD_CONV, XBC_WIDTH), SSD_CONV ** -0.5),
        "ssd_conv_b": nrm((DEPTH, XBC_WIDTH), 0.02),
        "ssd_dt_bias": dt_bias,
        "ssd_a_log": a_log,
        "ssd_d": 1.0 + nrm((DEPTH, SSD_HEADS), 0.1),
        "ssd_norm_g": 1.0 + nrm((DEPTH, SSD_INNER), 0.1),
        "w_ssd_out": nrm((DEPTH, SSD_INNER, D), SSD_INNER ** -0.5),
        "sc_conv_w": nrm((DEPTH, SC_CONV, SC_WIDTH), SC_CONV ** -0.5),
        "w_sc_out": nrm((DEPTH, SC_WIDTH, D), SC_WIDTH ** -0.5),
        "w_o": nrm((DEPTH, D, D), D ** -0.5),
        "ffn_w1": nrm((N_DENSE, D, FFN_DENSE), D ** -0.5),
        "ffn_w3": nrm((N_DENSE, D, FFN_DENSE), D ** -0.5),
        "ffn_w2": nrm((N_DENSE, FFN_DENSE, D), FFN_DENSE ** -0.5),
        "router_w": nrm((N_MOE, D, N_EXPERTS), D ** -0.5),
        "moe_w1": nrm((N_MOE, N_EXPERTS, D, FFN_EXPERT), D ** -0.5),
        "moe_w3": nrm((N_MOE, N_EXPERTS, D, FFN_EXPERT), D ** -0.5),
        "moe_w2": nrm((N_MOE, N_EXPERTS, FFN_EXPERT, D), FFN_EXPERT ** -0.5),
        "final_g": 1.0 + nrm((D,), 0.1),
    }


def reference(x, c, ctx, c_ctx, w_mod, b_mod, norm1_g, norm2_g, w_in, b_gate, ssd_conv_w,
              ssd_conv_b, ssd_dt_bias, ssd_a_log, ssd_d, ssd_norm_g, w_ssd_out, sc_conv_w,
              w_sc_out, w_o, ffn_w1, ffn_w3, ffn_w2, router_w, moe_w1, moe_w3, moe_w2, final_g):
    b = x.shape[0]
    rows = x.shape[1] // GRID_W
    for i in range(DEPTH):
        last = i == DEPTH - 1
        mx = (jax.nn.silu(c) @ w_mod[i] + b_mod[i]).reshape(b, N_MOD, 1, D_MODEL)
        mc = (jax.nn.silu(c_ctx) @ w_mod[i] + b_mod[i]).reshape(N_MOD, D_MODEL)
        mix_p = (w_in[i], b_gate[i], ssd_conv_w[i], ssd_conv_b[i], ssd_dt_bias[i], ssd_a_log[i],
                 ssd_d[i], ssd_norm_g[i], w_ssd_out[i], sc_conv_w[i], w_sc_out[i], w_o[i])

        hc = modulate(rmsnorm(ctx, norm1_g[i]), mc[0], mc[1])
        hx = modulate(rmsnorm(x, norm1_g[i]), mx[:, 0], mx[:, 1])
        if last:
            s_f, s_b = context_states(hc, w_in[i], ssd_conv_w[i], ssd_conv_b[i], ssd_dt_bias[i], ssd_a_log[i])
        else:
            zeros = jnp.zeros((b, SSD_GROUPS, SSD_HPG, SSD_HEAD_DIM, SSD_STATE), jnp.float32)
            yc, s_f, s_b = token_mixer(hc, zeros, zeros, None, *mix_p)
            ctx = ctx + mc[2] * yc
        yx, _, _ = token_mixer(hx, s_f, s_b, rows, *mix_p)
        x = x + mx[:, 2] * yx

        hx = modulate(rmsnorm(x, norm2_g[i]), mx[:, 3], mx[:, 4])
        x = x + mx[:, 5] * channel_mixer(hx, i, ffn_w1, ffn_w3, ffn_w2, router_w, moe_w1, moe_w3, moe_w2)
        if not last:
            hc = modulate(rmsnorm(ctx, norm2_g[i]), mc[3], mc[4])
            ctx = ctx + mc[5] * channel_mixer(hc, i, ffn_w1, ffn_w3, ffn_w2, router_w, moe_w1, moe_w3, moe_w2)
    return rmsnorm(x, final_g)
```

```cpp
#include <hip/hip_runtime.h>
#include <cstdio>
#include <cstdint>

#ifndef MK_SKELETON
#define MK_SKELETON 0
#endif
#ifndef PH_MASK
#define PH_MASK 0xFFFFFFFFu
#endif
#define PH(n) (!MK_SKELETON && ((PH_MASK >> (n)) & 1u))
#ifndef FFN_F8
#define FFN_F8 1
#endif
#ifndef PH_REPEAT
#define PH_REPEAT 0u
#endif
#define NREP(n) (((PH_REPEAT >> (n)) & 1u) ? 2 : 1)

#define GAS __attribute__((address_space(1)))
#define LAS __attribute__((address_space(3)))
typedef unsigned short bf16;
typedef unsigned v4u __attribute__((ext_vector_type(4)));
typedef unsigned v2u __attribute__((ext_vector_type(2)));
typedef float f32x4 __attribute__((ext_vector_type(4)));
typedef float f32x2 __attribute__((ext_vector_type(2)));
typedef short bf16x8 __attribute__((ext_vector_type(8)));

constexpr int D = 1024, NB = 8, SEQ = 4096, CTXL = 256, DEPTH = 2;
constexpr int T = NB * SEQ, TC = NB * CTXL, MR = T + TC;
constexpr int SSDI = 2048, NHEAD = 32, HDIM = 64, NGRP = 4, NST = 128, XBCW = 3072;
constexpr int INW = 10304, NMOD = 6;
constexpr int FFD = 2816, NEXP = 8, FFE = 3584;
constexpr float EPS = 1e-6f;
constexpr int C_Z = 0, C_XBC = 2048, C_DT = 5120, C_GB = 5184, C_GC = 6208, C_HV = 7232, C_G0 = 8256, C_G1 = 9280;
constexpr int WIN_A = 0, WIN_A_N = 3328;
constexpr int WIN_B = 3328, WIN_B_N = 5120;
constexpr int WIN_C = 8448, WIN_C_N = 2048;
constexpr int WIN_ROWS = 10496;

constexpr size_t MiB = 1u << 20;
constexpr size_t WS_CTL = 0, CTL_ZERO_BYTES = 1 * MiB;
constexpr size_t WS_MOD = 1 * MiB;
constexpr size_t WS_RSS = 2 * MiB;
constexpr size_t WS_TOPI = 3 * MiB, WS_TOPW = WS_TOPI + 512 * 1024, WS_TOKPOS = 4 * MiB, WS_ROWLIST = WS_TOKPOS + 512 * 1024, WS_GATEW = 5 * MiB, WS_CNTWG = WS_GATEW + 512 * 1024, WS_MOEINFO = WS_CNTWG + 256 * 1024;
constexpr size_t WS_DT = 6 * MiB;
constexpr size_t WS_CTXS = 15 * MiB;
constexpr size_t WS_WIN = 24 * MiB, WIN_STRIDE = 21 * MiB;
constexpr size_t WS_WSSD = 66 * MiB, WSSD_STRIDE = 4 * MiB;
constexpr size_t WS_WSC = 74 * MiB, WSC_STRIDE = 2 * MiB;
constexpr size_t WS_WO = 78 * MiB, WO_STRIDE = 2 * MiB;
constexpr size_t WS_W13 = 82 * MiB;
constexpr size_t WS_W2 = 93 * MiB;
constexpr size_t WS_R1 = 100 * MiB, WS_R2 = 304 * MiB, WS_HB = 508 * MiB, WS_END = 606 * MiB;
constexpr size_t WS_XBC = WS_R1, WS_Y = WS_R1, WS_Y1 = WS_R1 + 136 * MiB;
constexpr size_t WS_XBCC = WS_R2, WS_U = WS_R2, WS_GB = WS_R2 + 68 * MiB, WS_V = WS_R2 + 136 * MiB, WS_Y2 = WS_R2, WS_MRG = WS_R2 + 68 * MiB, WS_HF = WS_R2;
constexpr size_t WS_MW13 = 24 * MiB, WS_MW2 = 80 * MiB, WS_AG = 108 * MiB, WS_HM = 174 * MiB, WS_YM = 406 * MiB, WS_H8 = 544 * MiB;
constexpr size_t WS_ACS = 576 * MiB, WS_WW = 585 * MiB, WS_EA = 594 * MiB;
constexpr size_t XS_ELEMS = (size_t)MR * SSDI, BS_ELEMS = (size_t)MR * 512;
constexpr size_t WS_RSSP = 595 * MiB;
constexpr int MOE_GT = 272;
constexpr float MOE_WS1 = 32.f, MOE_WS2 = 64.f;
constexpr int CW_BAR = 4096;

constexpr int NWAVES = 8, NTHR = 512;
constexpr int LDS_BYTES = 155648;
constexpr int MISC_OFF = 131072 + 320;

__device__ __forceinline__ unsigned f2bf(float f) { unsigned u = __builtin_bit_cast(unsigned, f); return (u + 0x7fffu + ((u >> 16) & 1u)) >> 16; }
__device__ __forceinline__ float bf2f(unsigned h) { return __builtin_bit_cast(float, h << 16); }
__device__ __forceinline__ unsigned cvt_pk_bf16(float lo, float hi) { unsigned r; asm volatile("v_cvt_pk_bf16_f32 %0, %1, %2" : "=v"(r) : "v"(lo), "v"(hi)); return r; }
__device__ __forceinline__ float bflo(unsigned w) { return __builtin_bit_cast(float, w << 16); }
__device__ __forceinline__ float bfhi(unsigned w) { return __builtin_bit_cast(float, w & 0xffff0000u); }
__device__ __forceinline__ float wave_sum(float v) {
#pragma unroll
    for (int o = 1; o < 64; o <<= 1) v += __shfl_xor(v, o);
    return v;
}
__device__ __forceinline__ float siluf(float x) { return x * __builtin_amdgcn_rcpf(1.0f + __expf(-x)); }
__device__ __forceinline__ float sigmf(float x) { return __builtin_amdgcn_rcpf(1.0f + __expf(-x)); }
__device__ __forceinline__ float softplusf(float x) { return fmaxf(x, 0.f) + log1pf(__expf(-fabsf(x))); }
__device__ __forceinline__ float sat_fp8(float v) { return __builtin_amdgcn_fmed3f(v, -448.0f, 448.0f); }
__device__ __forceinline__ unsigned pk4_fp8(float a, float b, float c, float d) { int p = __builtin_amdgcn_cvt_pk_fp8_f32(sat_fp8(a), sat_fp8(b), 0, false); p = __builtin_amdgcn_cvt_pk_fp8_f32(sat_fp8(c), sat_fp8(d), p, true); return (unsigned)p; }
__device__ __forceinline__ float dpp_ror1(float v) { return __builtin_bit_cast(float, __builtin_amdgcn_mov_dpp(__builtin_bit_cast(int, v), 0x121, 0xf, 0xf, false)); }
__device__ __forceinline__ float dpp_rol1(float v) { return __builtin_bit_cast(float, __builtin_amdgcn_mov_dpp(__builtin_bit_cast(int, v), 0x12F, 0xf, 0xf, false)); }
__device__ __forceinline__ f32x2 rcp1pexp2(f32x2 v) { const f32x2 t = v * -1.44269504f; f32x2 e; e[0] = __builtin_amdgcn_exp2f(t[0]); e[1] = __builtin_amdgcn_exp2f(t[1]); const f32x2 d = e + 1.0f; f32x2 r; r[0] = __builtin_amdgcn_rcpf(d[0]); r[1] = __builtin_amdgcn_rcpf(d[1]); return r; }
__device__ __forceinline__ f32x2 silu2(f32x2 v) { return v * rcp1pexp2(v); }
__device__ __forceinline__ f32x2 sigm2(f32x2 v) { return rcp1pexp2(v); }
__device__ __forceinline__ f32x2 lo2(f32x4 v) { return (f32x2){v[0], v[1]}; }
__device__ __forceinline__ f32x2 hi2(f32x4 v) { return (f32x2){v[2], v[3]}; }
__device__ __forceinline__ f32x2 bf2x(unsigned w) { return (f32x2){bflo(w), bfhi(w)}; }
#define LDS_WAIT() asm volatile("s_waitcnt lgkmcnt(0)" ::: "memory")
#define VM_WAIT() asm volatile("s_waitcnt vmcnt(0)" ::: "memory")

#define XB_TMO      128
#define XB_XCNT(j)  (256  + 64 * (j))
#define XB_XSUB(j)  (1280 + 64 * (j))
#define XB_XGEN(j)  (2304 + 64 * (j))
#define XB_TOP      3328
#define XB_TOPGEN   3392
#define XCD_BAR_WORDS 3456
#define XB_SPIN_CAP (1u << 18)
__device__ __forceinline__ unsigned xb_ld(unsigned* p)              { return __hip_atomic_load(p, __ATOMIC_RELAXED, __HIP_MEMORY_SCOPE_AGENT); }
__device__ __forceinline__ unsigned xb_add(unsigned* p, unsigned v) { return __hip_atomic_fetch_add(p, v, __ATOMIC_RELAXED, __HIP_MEMORY_SCOPE_AGENT); }
__device__ __forceinline__ unsigned xb_xcc_id() { return (unsigned)__builtin_amdgcn_s_getreg((3 << 11) | 20) & 0xFu; }
#define XB_SPIN(cond, bar) do { unsigned _sp = 0; while (cond) { __builtin_amdgcn_s_sleep(1); \
    if ((++_sp & 255u) == 0u) { if (xb_ld(&(bar)[XB_TMO])) break; if (_sp > XB_SPIN_CAP) { atomicAdd(&(bar)[XB_TMO], 1u); break; } } } } while (0)
struct XcdBarrier { unsigned* bar; unsigned x; volatile LAS unsigned* st; };
__device__ __forceinline__ XcdBarrier xcd_barrier_post(unsigned* bar, volatile LAS unsigned* st) {
    XcdBarrier b; b.bar = bar; b.x = xb_xcc_id(); b.st = st;
    if (threadIdx.x == 0) (void)xb_add(&bar[XB_XCNT(b.x)], 1u);
    return b;
}
__device__ __forceinline__ void xcd_barrier_complete(unsigned* bar, unsigned x, unsigned& nloc, unsigned& nx) {
    const unsigned G = gridDim.x * gridDim.y * gridDim.z;
    unsigned sum, cnt, mine, sp = 0u;
    for (;;) {
        sum = 0u; cnt = 0u; mine = 0u;
#pragma unroll
        for (unsigned j = 0; j < 16; ++j) { const unsigned c = xb_ld(&bar[XB_XCNT(j)]); sum += c; cnt += (c > 0u) ? 1u : 0u; mine = (j == x) ? c : mine; }
        if (sum == G) break;
        __builtin_amdgcn_s_sleep(1);
        if ((++sp & 255u) == 0u) { if (xb_ld(&bar[XB_TMO])) break; if (sp > XB_SPIN_CAP) { atomicAdd(&bar[XB_TMO], 1u); break; } }
    }
    nloc = mine > 0u ? mine : 1u; nx = cnt > 0u ? cnt : 1u;
}
__device__ __forceinline__ void xcd_barrier(const XcdBarrier& b) {
    asm volatile("s_waitcnt vmcnt(0)" ::: "memory");
    __syncthreads();
    if (threadIdx.x == 0) {
        unsigned* bar = b.bar;
        __builtin_amdgcn_s_waitcnt(0);
        unsigned nloc = b.st[0], nx = b.st[1];
        if (nloc == 0u) { xcd_barrier_complete(bar, b.x, nloc, nx); b.st[0] = nloc; b.st[1] = nx; }
        const unsigned old = xb_add(&bar[XB_XSUB(b.x)], 1u);
        const unsigned gen = old / nloc;
        if (old + 1u == (gen + 1u) * nloc) {
            __builtin_amdgcn_fence(__ATOMIC_RELEASE, "agent");
            asm volatile("s_waitcnt vmcnt(0)" ::: "memory");
            const unsigned og = xb_add(&bar[XB_TOP], 1u);
            const unsigned tg = og / nx;
            if (og + 1u == (tg + 1u) * nx) xb_add(&bar[XB_TOPGEN], 1u);
            else XB_SPIN(xb_ld(&bar[XB_TOPGEN]) == tg, bar);
            __builtin_amdgcn_fence(__ATOMIC_ACQUIRE, "agent");
            xb_add(&bar[XB_XGEN(b.x)], 1u);
            asm volatile("s_waitcnt vmcnt(0)" ::: "memory");
        } else {
            XB_SPIN(xb_ld(&bar[XB_XGEN(b.x)]) == gen, bar);
            __builtin_amdgcn_fence(__ATOMIC_ACQUIRE, "agent");
            asm volatile("s_waitcnt vmcnt(0)" ::: "memory");
        }
    }
    __syncthreads();
}

namespace pg8 {
constexpr int BM = 256, BK = 64, HALF = 128, HTB = HALF * BK * 2, STAGE_BYTES = 8 * HTB, NXCD = 8, WGM = 8;
__host__ __device__ __forceinline__ int lds_byte(int r, int c) { const int st = (r >> 4) * 2 + (c >> 5), rr = r & 15, cc = c & 31, ob = rr * 64 + cc * 2; return st * 1024 + (ob ^ (((ob >> 9) & 1) << 5)); }
__host__ __device__ __forceinline__ void stage_rc(int b, int& R, int& C) { const int st = b / 1024, sb = b % 1024, swz = sb ^ (((sb >> 9) & 1) << 5); R = (st >> 1) * 16 + swz / 64; C = (st & 1) * 32 + (swz % 64) / 2; }
__host__ __device__ __forceinline__ int perm32(int rho) { const int n = rho >> 4, i = rho & 15; return 8 * (i >> 2) + 4 * n + (i & 3); }

struct Unit { const char* A; const char* B; int pm, pn; };
typedef int v4i_ __attribute__((ext_vector_type(4))); typedef int v8i_ __attribute__((ext_vector_type(8)));
__device__ __forceinline__ v8i_ cat8(bf16x8 a, bf16x8 b) { const v4i_ x = __builtin_bit_cast(v4i_, a), y = __builtin_bit_cast(v4i_, b); return __builtin_shufflevector(x, y, 0, 1, 2, 3, 4, 5, 6, 7); }
__device__ __forceinline__ bf16x8 lo8(v8i_ v) { const v4i_ x = __builtin_shufflevector(v, v, 0, 1, 2, 3); return __builtin_bit_cast(bf16x8, x); }
__device__ __forceinline__ bf16x8 hi8(v8i_ v) { const v4i_ x = __builtin_shufflevector(v, v, 4, 5, 6, 7); return __builtin_bit_cast(bf16x8, x); }

template <class Epi, class Sched, bool F8 = false, bool VARK = false>
__device__ __forceinline__ void gemm_phase(LAS unsigned char* lds, const int KB, const Sched& S, const Epi& E) {
    int tid = threadIdx.x; asm volatile("" : "+v"(tid));
    const int wid = __builtin_amdgcn_readfirstlane(tid >> 6), lane = tid & 63, wr = wid >> 2, wc = wid & 3, fr = lane & 15, fq = lane >> 4;
    int nt = KB / 128;
    int f8scale = 0x7f7f7f7f; asm volatile("" : "+v"(f8scale));
    unsigned voffA[2], voffB[2];
#pragma unroll
    for (int i = 0; i < 2; ++i) { int R, C; stage_rc(tid * 16 + i * 8192, R, C); const int Rb = (R & ~31) + perm32(R & 31);
        voffA[i] = (unsigned)(R * KB + C * 2); voffB[i] = (unsigned)(Rb * KB + C * 2); }
    const size_t kstep = (size_t)(BK * 2);
    const size_t hstep = (size_t)HALF * KB;
    const unsigned ldsw = (unsigned)wid * 1024u;
    const int aoff = lds_byte(wr * 64 + fr, fq * 8), boff = lds_byte(wc * 32 + fr, fq * 8);
#define PG8_SA(b, h) (((b) * 2 + (h)) * HTB)
#define PG8_SB(b, h) ((4 + (b) * 2 + (h)) * HTB)
#define PG8_STAGE(bufoff, gbase, voff) do { _Pragma("unroll") for (int _i = 0; _i < 2; ++_i) \
        __builtin_amdgcn_global_load_lds((const unsigned*)((const char*)(gbase) + (voff)[_i]), (LAS unsigned*)(lds + (bufoff) + ldsw + _i * 8192), 16, 0, 0); } while (0)
#define PG8_LDA(dst, b, h) do { _Pragma("unroll") for (int m = 0; m < 4; ++m) dst[m] = cat8(*(const LAS bf16x8*)(lds + PG8_SA(b, h) + aoff + m * 2048), *(const LAS bf16x8*)(lds + PG8_SA(b, h) + aoff + m * 2048 + 1024)); } while (0)
#define PG8_LDB(dst, b, h) do { _Pragma("unroll") for (int n = 0; n < 2; ++n) dst[n] = cat8(*(const LAS bf16x8*)(lds + PG8_SB(b, h) + boff + n * 2048), *(const LAS bf16x8*)(lds + PG8_SB(b, h) + boff + n * 2048 + 1024)); } while (0)
#define PG8_MMA(ai, bj, At, Bt) do { __builtin_amdgcn_s_setprio(1); _Pragma("unroll") for (int m = 0; m < 4; ++m) _Pragma("unroll") for (int n = 0; n < 2; ++n) { \
        if constexpr (F8) asm volatile("v_mfma_scale_f32_16x16x128_f8f6f4 %0, %1, %2, %0, %3, %3 op_sel_hi:[0,0,0]" : "+v"(acc[ai][bj][m][n]) : "v"(Bt[n]), "v"(At[m]), "v"(f8scale)); \
        else { acc[ai][bj][m][n] = __builtin_amdgcn_mfma_f32_16x16x32_bf16(lo8(Bt[n]), lo8(At[m]), acc[ai][bj][m][n], 0, 0, 0); acc[ai][bj][m][n] = __builtin_amdgcn_mfma_f32_16x16x32_bf16(hi8(Bt[n]), hi8(At[m]), acc[ai][bj][m][n], 0, 0, 0); } } __builtin_amdgcn_s_setprio(0); } while (0)
#define PG8_WAIT_V(n) asm volatile("s_waitcnt vmcnt(" #n ")" ::: "memory")
#define PG8_WAIT_L(n) asm volatile("s_waitcnt lgkmcnt(" #n ")" ::: "memory")
#define PG8_BAR __builtin_amdgcn_s_barrier()
#define PG8_SCHED __builtin_amdgcn_sched_barrier(0)
    Unit cur, nxt; int ui = 0;
    if (!S.next(0, cur)) return;
    if constexpr (VARK) { nt = S.nkt(0); asm volatile("" : "+s"(nt)); }
    f32x4 acc[2][2][4][2];
#pragma unroll
    for (int a = 0; a < 2; ++a)
#pragma unroll
        for (int b = 0; b < 2; ++b)
#pragma unroll
            for (int m = 0; m < 4; ++m)
#pragma unroll
                for (int n = 0; n < 2; ++n) acc[a][b][m][n] = (f32x4){0.f, 0.f, 0.f, 0.f};
    v8i_ At[4], B0[2], B1[2];
    const char* cA = cur.A; const char* cB = cur.B;
    PG8_STAGE(PG8_SB(0, 0), cB, voffB); PG8_STAGE(PG8_SB(0, 1), cB + hstep, voffB); PG8_STAGE(PG8_SA(0, 0), cA, voffA); PG8_STAGE(PG8_SA(0, 1), cA + hstep, voffA);
    if (wr == 1) PG8_BAR;
    PG8_WAIT_V(2); PG8_BAR;
    PG8_STAGE(PG8_SB(1, 0), cB + kstep, voffB); PG8_STAGE(PG8_SA(1, 0), cA + kstep, voffA); PG8_STAGE(PG8_SB(1, 1), cB + hstep + kstep, voffB);
    PG8_WAIT_V(6); PG8_BAR;
    for (;;) {
        const bool has_next = S.next(ui + 1, nxt);
        const char* nA = has_next ? nxt.A : cA; const char* nB = has_next ? nxt.B : cB;
        for (int t = 0; t < nt; t += 2) {
            const bool last = (t == nt - 2);
            const char* a1 = cA + (size_t)(t + 1) * kstep;
            const char* a2 = last ? nA : cA + (size_t)(t + 2) * kstep; const char* b2 = last ? nB : cB + (size_t)(t + 2) * kstep;
            const char* a3 = a2 + kstep; const char* b3 = b2 + kstep;
            PG8_LDB(B0, 0, 0); PG8_LDB(B1, 0, 1); PG8_SCHED; PG8_LDA(At, 0, 0); PG8_STAGE(PG8_SA(1, 1), a1 + hstep, voffA);
            PG8_WAIT_V(8); PG8_WAIT_L(0); PG8_BAR; PG8_MMA(0, 0, At, B0); PG8_MMA(0, 1, At, B1); PG8_BAR; PG8_SCHED;
            PG8_LDA(At, 0, 1); PG8_STAGE(PG8_SB(0, 0), b2, voffB); PG8_STAGE(PG8_SB(0, 1), b2 + hstep, voffB); PG8_STAGE(PG8_SA(0, 0), a2, voffA);
            PG8_WAIT_V(8); PG8_WAIT_L(0); PG8_BAR; PG8_MMA(1, 0, At, B0); PG8_MMA(1, 1, At, B1); PG8_BAR; PG8_SCHED;
            PG8_LDB(B0, 1, 0); PG8_LDB(B1, 1, 1); PG8_SCHED; PG8_LDA(At, 1, 0); PG8_STAGE(PG8_SA(0, 1), a2 + hstep, voffA);
            PG8_WAIT_V(8); PG8_WAIT_L(0); PG8_BAR; PG8_MMA(0, 0, At, B0); PG8_MMA(0, 1, At, B1); PG8_BAR; PG8_SCHED;
            PG8_LDA(At, 1, 1); PG8_STAGE(PG8_SB(1, 0), b3, voffB); PG8_STAGE(PG8_SB(1, 1), b3 + hstep, voffB); PG8_STAGE(PG8_SA(1, 0), a3, voffA);
            PG8_WAIT_V(8); PG8_WAIT_L(0); PG8_BAR; PG8_MMA(1, 0, At, B0); PG8_MMA(1, 1, At, B1); PG8_BAR; PG8_SCHED;
        }
        if (wr == 0) PG8_BAR;
        E(acc, cur, wr, wc, fr, fq);
        if (!has_next) break;
#pragma unroll
        for (int a = 0; a < 2; ++a)
#pragma unroll
            for (int b = 0; b < 2; ++b)
#pragma unroll
                for (int m = 0; m < 4; ++m)
#pragma unroll
                    for (int n = 0; n < 2; ++n) acc[a][b][m][n] = (f32x4){0.f, 0.f, 0.f, 0.f};
        cur = nxt; cA = nA; cB = nB; ++ui;
        if constexpr (VARK) { nt = S.nkt(ui); asm volatile("" : "+s"(nt)); }
        if (wr == 1) PG8_BAR;
    }
    PG8_WAIT_V(0);
    PG8_BAR;
#undef PG8_SA
#undef PG8_SB
#undef PG8_STAGE
#undef PG8_LDA
#undef PG8_LDB
#undef PG8_MMA
#undef PG8_WAIT_V
#undef PG8_WAIT_L
#undef PG8_BAR
#undef PG8_SCHED
}

struct GridSched {
    int nM, nN, nwg, G, c, pm0; const char* A; const char* B; size_t tstepA, tstepB;
    __device__ __forceinline__ void init(int nM_, int nN_, int pm0_, int G_, int c_, const void* A_, const void* B_, int KB) { nM = nM_; nN = nN_; nwg = nM * nN; G = G_; c = c_; pm0 = pm0_; A = (const char*)A_; B = (const char*)B_; tstepA = (size_t)BM * KB; tstepB = tstepA; }
    __device__ __forceinline__ bool next(int i, Unit& u) const {
        const long L = (long)i * G + c; if (L >= nwg) return false;
        int wgid = (int)L; { const int q = nwg / NXCD, r = nwg % NXCD, xcd = wgid % NXCD, off = wgid / NXCD; wgid = (xcd < r ? xcd * (q + 1) : r * (q + 1) + (xcd - r) * q) + off; }
        const int nig = WGM * nN, gid = wgid / nig, fm = gid * WGM, gsz = (nM - fm) < WGM ? (nM - fm) : WGM;
        const int pm = fm + ((wgid % nig) % gsz), pn = (wgid % nig) / gsz;
        u.pm = pm0 + pm; u.pn = pn; u.A = A + (size_t)u.pm * tstepA; u.B = B + (size_t)pn * tstepB; return true;
    }
};
}
using pg8::Unit;

struct Args { const float* in[28]; float* out; unsigned char* ws; };
enum { I_X = 0, I_C, I_CTX, I_CCTX, I_WMOD, I_BMOD, I_N1G, I_N2G, I_WIN, I_BGATE, I_SCW, I_SCB, I_DTB, I_ALOG, I_SSDD, I_SNG, I_WSSD, I_SCCW, I_WSC, I_WO, I_F1, I_F3, I_F2, I_RW, I_M1, I_M3, I_M2, I_FG };


#define EPI_FOR_ROWS(ai, m) _Pragma("unroll") for (int ai = 0; ai < 2; ++ai) _Pragma("unroll") for (int m = 0; m < 4; ++m)

struct EpiXbcConv {
    bf16* XC; float* DT; const float* dtb; const float* cw; const float* cb; float* RAWB; LAS float* ex;
    __device__ __forceinline__ void operator()(const f32x4 (&acc)[2][2][4][2], const Unit& u, int wr, int wc, int fr, int fq) const {
        const int row0 = u.pm * 256 + wr * 64 + fr;
        if (u.pn < 12) {
            const int cs = wc * 32 + 8 * fq;
            const int col0 = u.pn * 256 + cs;
#pragma unroll
            for (int ai = 0; ai < 2; ++ai) { const int k = 2 * ai + wr;
                if (fr == 0) {
#pragma unroll
                    for (int bj = 0; bj < 2; ++bj)
#pragma unroll
                        for (int n = 0; n < 2; ++n) *(LAS f32x4*)(ex + (k * 2 + 0) * 256 + cs + 128 * bj + 4 * n) = acc[ai][bj][0][n]; }
                if (fr == 15) {
#pragma unroll
                    for (int bj = 0; bj < 2; ++bj)
#pragma unroll
                        for (int n = 0; n < 2; ++n) *(LAS f32x4*)(ex + (k * 2 + 1) * 256 + cs + 128 * bj + 4 * n) = acc[ai][bj][3][n]; } }
            if (wr == 0 && fr < 2) {
#pragma unroll
                for (int bj = 0; bj < 2; ++bj)
#pragma unroll
                    for (int n = 0; n < 2; ++n) *(f32x4*)(RAWB + ((size_t)(u.pm * 4 + fr) * XBCW + col0 + 128 * bj + 4 * n)) = acc[0][bj][0][n]; }
            if (wr == 1 && fr >= 14) {
#pragma unroll
                for (int bj = 0; bj < 2; ++bj)
#pragma unroll
                    for (int n = 0; n < 2; ++n) *(f32x4*)(RAWB + ((size_t)(u.pm * 4 + 2 + (fr - 14)) * XBCW + col0 + 128 * bj + 4 * n)) = acc[1][bj][3][n]; }
            asm volatile("s_waitcnt lgkmcnt(0)" ::: "memory"); __builtin_amdgcn_s_barrier(); asm volatile("" ::: "memory");
#pragma unroll
            for (int bj = 0; bj < 2; ++bj) {
                const int c8 = col0 + 128 * bj;
                f32x4 w0[2], w1[2], w2[2], bb[2];
#pragma unroll
                for (int n = 0; n < 2; ++n) { w0[n] = *(const f32x4*)(cw + c8 + 4 * n); w1[n] = *(const f32x4*)(cw + XBCW + c8 + 4 * n); w2[n] = *(const f32x4*)(cw + 2 * XBCW + c8 + 4 * n); bb[n] = *(const f32x4*)(cb + c8 + 4 * n); }
                bf16* dcol; int dstride, dchunk;
                if (c8 < 2048) { dcol = XC + ((size_t)(u.pm * 4 * 32 + (c8 >> 6)) * 4096 + (c8 & 63)); dstride = 64; dchunk = 32 * 4096; }
                else if (c8 < 2560) { dcol = XC + XS_ELEMS + ((size_t)(u.pm * 4 * 4 + ((c8 - 2048) >> 7)) * 8192 + ((c8 - 2048) & 127)); dstride = 128; dchunk = 4 * 8192; }
                else { dcol = XC + XS_ELEMS + BS_ELEMS + ((size_t)(u.pm * 4 * 4 + ((c8 - 2560) >> 7)) * 8192 + ((c8 - 2560) & 127)); dstride = 128; dchunk = 4 * 8192; }
#pragma unroll
                for (int ai = 0; ai < 2; ++ai) { const int k = 2 * ai + wr;
                    const f32x4 zero4 = (f32x4){0.f, 0.f, 0.f, 0.f};
                    f32x4 ep[2], en[2];
#pragma unroll
                    for (int n = 0; n < 2; ++n) { ep[n] = (k > 0) ? *(const LAS f32x4*)(ex + ((k - 1) * 2 + 1) * 256 + cs + 128 * bj + 4 * n) : zero4; en[n] = (k < 3) ? *(const LAS f32x4*)(ex + ((k + 1) * 2 + 0) * 256 + cs + 128 * bj + 4 * n) : zero4; }
                    bf16* dbase = dcol + (size_t)k * dchunk;
                    float rprev[8], lcur[8];
#pragma unroll
                    for (int n = 0; n < 2; ++n)
#pragma unroll
                        for (int j = 0; j < 4; ++j) { rprev[4 * n + j] = ep[n][j]; lcur[4 * n + j] = dpp_rol1(acc[ai][bj][0][n][j]); }
#pragma unroll
                    for (int m = 0; m < 4; ++m) { float o[8], lnext[8];
#pragma unroll
                        for (int n = 0; n < 2; ++n)
#pragma unroll
                            for (int jp = 0; jp < 2; ++jp) {
                                f32x2 xv, pvv, nxv;
#pragma unroll
                                for (int q = 0; q < 2; ++q) { const int j = 2 * jp + q, e = 4 * n + j; const float x = acc[ai][bj][m][n][j];
                                    const float rme = dpp_ror1(x);
                                    lnext[e] = m < 3 ? dpp_rol1(acc[ai][bj][m < 3 ? m + 1 : 3][n][j]) : en[n][j];
                                    xv[q] = x; pvv[q] = (fr == 0) ? rprev[e] : rme; nxv[q] = (fr == 15) ? lnext[e] : lcur[e];
                                    rprev[e] = rme; }
                                const f32x2 w0p = (f32x2){w0[n][2 * jp], w0[n][2 * jp + 1]}, w1p = (f32x2){w1[n][2 * jp], w1[n][2 * jp + 1]}, w2p = (f32x2){w2[n][2 * jp], w2[n][2 * jp + 1]}, bbp = (f32x2){bb[n][2 * jp], bb[n][2 * jp + 1]};
                                const f32x2 v = __builtin_elementwise_fma(w0p, pvv, __builtin_elementwise_fma(w1p, xv, __builtin_elementwise_fma(w2p, nxv, bbp)));
                                const f32x2 t = v * -1.44269504f;
                                f32x2 ex; ex[0] = __builtin_amdgcn_exp2f(t[0]); ex[1] = __builtin_amdgcn_exp2f(t[1]);
                                const f32x2 d = ex + 1.0f;
                                f32x2 r; r[0] = __builtin_amdgcn_rcpf(d[0]); r[1] = __builtin_amdgcn_rcpf(d[1]);
                                const f32x2 ov = v * r;
                                o[4 * n + 2 * jp] = ov[0]; o[4 * n + 2 * jp + 1] = ov[1]; }
#pragma unroll
                        for (int e = 0; e < 8; ++e) lcur[e] = lnext[e];
                        v4u w; w.x = cvt_pk_bf16(o[0], o[1]); w.y = cvt_pk_bf16(o[2], o[3]); w.z = cvt_pk_bf16(o[4], o[5]); w.w = cvt_pk_bf16(o[6], o[7]);
                        *(v4u*)(dbase + (size_t)(16 * m + fr) * dstride) = w; } } }
        } else if (wc < 2) {
            const int col0 = wc * 32 + 8 * fq;
            const f32x4 b0 = *(const f32x4*)(dtb + col0), b1 = *(const f32x4*)(dtb + col0 + 4);
            EPI_FOR_ROWS(ai, m) { float* rowp = DT + (size_t)(row0 + ai * 128 + m * 16) * 64 + col0;
                const f32x4 v0 = acc[ai][0][m][0] + b0, v1 = acc[ai][0][m][1] + b1; f32x4 o0, o1;
#pragma unroll
                for (int j = 0; j < 4; ++j) { o0[j] = softplusf(v0[j]); o1[j] = softplusf(v1[j]); }
                *(f32x4*)rowp = o0; *(f32x4*)(rowp + 4) = o1; }
        }
    }
};
struct EpiZsv {
    bf16* Y; bf16* V; float* rssp; const float* scw; LAS float* ex;
    __device__ __forceinline__ void operator()(const f32x4 (&acc)[2][2][4][2], const Unit& u, int wr, int wc, int fr, int fq) const {
        const int row0 = u.pm * 256 + wr * 64 + fr;
        if (u.pn < 16) {
            const int chl = 16 * wc + 4 * fq, ch0 = 64 * u.pn + chl;
            const bool isc = u.pm < 8;
            f32x4 uu[2][4]; v2u yin[2][4];
#pragma unroll
            for (int ai = 0; ai < 2; ++ai)
#pragma unroll
                for (int m = 0; m < 4; ++m) { uu[ai][m] = acc[ai][0][m][0] * acc[ai][0][m][1]; yin[ai][m] = *(const v2u*)(Y + (size_t)(row0 + ai * 128 + m * 16) * SSDI + ch0); }
            if (isc) {
#pragma unroll
                for (int ai = 0; ai < 2; ++ai) { const int k = 2 * ai + wr;
                    if (fr == 0) *(LAS f32x4*)(ex + (k * 2 + 0) * 64 + chl) = uu[ai][0];
                    if (fr == 15) *(LAS f32x4*)(ex + (k * 2 + 1) * 64 + chl) = uu[ai][3]; }
                asm volatile("s_waitcnt lgkmcnt(0)" ::: "memory"); __builtin_amdgcn_s_barrier(); asm volatile("" ::: "memory"); }
            const f32x4 w0 = *(const f32x4*)(scw + ch0), w1 = *(const f32x4*)(scw + D + ch0), w2 = *(const f32x4*)(scw + 2 * D + ch0);
#pragma unroll
            for (int ai = 0; ai < 2; ++ai) { const int k = 2 * ai + wr;
                const f32x4 zero4 = (f32x4){0.f, 0.f, 0.f, 0.f};
                const f32x4 ep = (isc && k > 0) ? *(const LAS f32x4*)(ex + ((k - 1) * 2 + 1) * 64 + chl) : zero4;
                const f32x4 en = (isc && k < 3) ? *(const LAS f32x4*)(ex + ((k + 1) * 2 + 0) * 64 + chl) : zero4;
                float rprev[4], lcur[4];
#pragma unroll
                for (int j = 0; j < 4; ++j) { rprev[j] = ep[j]; lcur[j] = dpp_rol1(uu[ai][0][j]); }
#pragma unroll
                for (int m = 0; m < 4; ++m) { const int row = row0 + ai * 128 + m * 16; float o[4], g[4], lnext[4], ss = 0.f;
                    bf16* yp = Y + (size_t)row * SSDI + ch0; const v2u yv = yin[ai][m];
#pragma unroll
                    for (int j = 0; j < 4; ++j) { const float x = uu[ai][m][j];
                        const float rme = dpp_ror1(x);
                        lnext[j] = m < 3 ? dpp_rol1(uu[ai][m < 3 ? m + 1 : 3][j]) : en[j];
                        const float pv = (fr == 0) ? rprev[j] : rme, nx = (fr == 15) ? lnext[j] : lcur[j];
                        o[j] = acc[ai][1][m][0][j] * __builtin_fmaf(w0[j], pv, __builtin_fmaf(w1[j], x, w2[j] * nx));
                        rprev[j] = rme; }
#pragma unroll
                    for (int j = 0; j < 4; ++j) lcur[j] = lnext[j];
                    { const f32x2 g0 = bf2x(yv.x) * silu2(lo2(acc[ai][1][m][1])), g1 = bf2x(yv.y) * silu2(hi2(acc[ai][1][m][1])); g[0] = g0[0]; g[1] = g0[1]; g[2] = g1[0]; g[3] = g1[1];
                      const f32x2 sq = g0 * g0 + g1 * g1; ss = sq[0] + sq[1]; }
                    v2u w; w.x = cvt_pk_bf16(o[0], o[1]); w.y = cvt_pk_bf16(o[2], o[3]); *(v2u*)(V + (size_t)row * D + ch0) = w;
                    v2u wy; wy.x = cvt_pk_bf16(g[0], g[1]); wy.y = cvt_pk_bf16(g[2], g[3]); *(v2u*)yp = wy;
                    ss += __shfl_xor(ss, 16); ss += __shfl_xor(ss, 32);
                    if (fq == 0) rssp[(size_t)row * 80 + u.pn * 4 + wc] = ss; } }
        } else {
            const int col0 = 1024 + (u.pn - 16) * 256 + wc * 32 + 8 * fq;
#pragma unroll
            for (int ai = 0; ai < 2; ++ai) {
                v4u yin[4][2];
#pragma unroll
                for (int m = 0; m < 4; ++m)
#pragma unroll
                    for (int bj = 0; bj < 2; ++bj) yin[m][bj] = *(const v4u*)(Y + (size_t)(row0 + ai * 128 + m * 16) * SSDI + col0 + bj * 128);
#pragma unroll
                for (int m = 0; m < 4; ++m) { const int row = row0 + ai * 128 + m * 16; bf16* rowp = Y + (size_t)row * SSDI + col0; float ss = 0.f;
#pragma unroll
                for (int bj = 0; bj < 2; ++bj) { const f32x4 z0 = acc[ai][bj][m][0], z1 = acc[ai][bj][m][1]; const v4u yv = yin[m][bj];
                    const f32x2 o0 = bf2x(yv.x) * silu2(lo2(z0)), o1 = bf2x(yv.y) * silu2(hi2(z0)), o2 = bf2x(yv.z) * silu2(lo2(z1)), o3 = bf2x(yv.w) * silu2(hi2(z1));
                    const f32x2 sq = (o0 * o0 + o1 * o1) + (o2 * o2 + o3 * o3); ss += sq[0] + sq[1];
                    v4u w; w.x = cvt_pk_bf16(o0[0], o0[1]); w.y = cvt_pk_bf16(o1[0], o1[1]); w.z = cvt_pk_bf16(o2[0], o2[1]); w.w = cvt_pk_bf16(o3[0], o3[1]);
                    *(v4u*)(rowp + bj * 128) = w; }
                ss += __shfl_xor(ss, 16); ss += __shfl_xor(ss, 32);
                if (fq == 0) rssp[(size_t)row * 80 + 64 + (u.pn - 16) * 4 + wc] = ss; } }
        }
    }
};
struct EpiRowScale {
    bf16* O; const float* rss;
    __device__ __forceinline__ void operator()(const f32x4 (&acc)[2][2][4][2], const Unit& u, int wr, int wc, int fr, int fq) const {
        const int row0 = u.pm * 256 + wr * 64 + fr, col0 = u.pn * 256 + wc * 32 + 8 * fq;
        EPI_FOR_ROWS(ai, m) { const int row = row0 + ai * 128 + m * 16; bf16* rowp = O + (size_t)row * D + col0;
            const float sc = rss ? rsqrtf(rss[row] * (1.0f / SSDI) + EPS) : 1.0f;
#pragma unroll
            for (int bj = 0; bj < 2; ++bj) { const f32x4 v0 = acc[ai][bj][m][0] * sc, v1 = acc[ai][bj][m][1] * sc;
                v4u w; w.x = cvt_pk_bf16(v0[0], v0[1]); w.y = cvt_pk_bf16(v0[2], v0[3]); w.z = cvt_pk_bf16(v1[0], v1[1]); w.w = cvt_pk_bf16(v1[2], v1[3]);
                *(v4u*)(rowp + bj * 128) = w; } }
    }
};
struct EpiGate {
    bf16* Mrg; const bf16* Y1; const bf16* Y2; const float* bg; const float* rss;
    const bf16* P1;
    __device__ __forceinline__ void operator()(const f32x4 (&acc)[2][2][4][2], const Unit& u, int wr, int wc, int fr, int fq) const {
        const int row0 = u.pm * 256 + wr * 64 + fr, ch0 = u.pn * 128 + wc * 32 + 8 * fq;
        const f32x4 b00 = *(const f32x4*)(bg + ch0), b01 = *(const f32x4*)(bg + ch0 + 4), b10 = *(const f32x4*)(bg + D + ch0), b11 = *(const f32x4*)(bg + D + ch0 + 4);
        if (P1 != nullptr && u.pm < 8) {
            EPI_FOR_ROWS(ai, m) { const size_t off = (size_t)(row0 + ai * 128 + m * 16) * D + ch0; const float rs = rsqrtf(rss[row0 + ai * 128 + m * 16] * (1.0f / SSDI) + EPS);
                f32x2 s1[4], s2[4];
#pragma unroll
                for (int k = 0; k < 4; ++k) { s1[k] = (f32x2){0.f, 0.f}; s2[k] = (f32x2){0.f, 0.f}; }
#pragma unroll
                for (int ks = 0; ks < 4; ++ks) { const v4u p = *(const v4u*)(P1 + (size_t)ks * TC * D + off); s1[0] += bf2x(p.x); s1[1] += bf2x(p.y); s1[2] += bf2x(p.z); s1[3] += bf2x(p.w); }
                { const v4u p = *(const v4u*)(Y2 + off); s2[0] = bf2x(p.x); s2[1] = bf2x(p.y); s2[2] = bf2x(p.z); s2[3] = bf2x(p.w); }
                const f32x4 g00 = acc[ai][0][m][0] + b00, g01 = acc[ai][0][m][1] + b01, g10 = acc[ai][1][m][0] + b10, g11 = acc[ai][1][m][1] + b11;
                const f32x2 o0 = sigm2(lo2(g00)) * (s1[0] * rs) + sigm2(lo2(g10)) * s2[0], o1 = sigm2(hi2(g00)) * (s1[1] * rs) + sigm2(hi2(g10)) * s2[1];
                const f32x2 o2 = sigm2(lo2(g01)) * (s1[2] * rs) + sigm2(lo2(g11)) * s2[2], o3 = sigm2(hi2(g01)) * (s1[3] * rs) + sigm2(hi2(g11)) * s2[3];
                v4u w; w.x = cvt_pk_bf16(o0[0], o0[1]); w.y = cvt_pk_bf16(o1[0], o1[1]); w.z = cvt_pk_bf16(o2[0], o2[1]); w.w = cvt_pk_bf16(o3[0], o3[1]);
                *(v4u*)(Mrg + off) = w; }
            return;
        }
#pragma unroll
        for (int ai = 0; ai < 2; ++ai) {
            v4u y1v[4], y2v[4]; float rsv[4];
#pragma unroll
            for (int m = 0; m < 4; ++m) { const size_t off = (size_t)(row0 + ai * 128 + m * 16) * D + ch0; y1v[m] = *(const v4u*)(Y1 + off); y2v[m] = *(const v4u*)(Y2 + off); rsv[m] = rss[row0 + ai * 128 + m * 16]; }
#pragma unroll
            for (int m = 0; m < 4; ++m) { const size_t off = (size_t)(row0 + ai * 128 + m * 16) * D + ch0; const float rs = rsqrtf(rsv[m] * (1.0f / SSDI) + EPS);
            const v4u y1 = y1v[m], y2 = y2v[m];
            const f32x4 g00 = acc[ai][0][m][0] + b00, g01 = acc[ai][0][m][1] + b01, g10 = acc[ai][1][m][0] + b10, g11 = acc[ai][1][m][1] + b11;
            const f32x2 o0 = sigm2(lo2(g00)) * (bf2x(y1.x) * rs) + sigm2(lo2(g10)) * bf2x(y2.x), o1 = sigm2(hi2(g00)) * (bf2x(y1.y) * rs) + sigm2(hi2(g10)) * bf2x(y2.y);
            const f32x2 o2 = sigm2(lo2(g01)) * (bf2x(y1.z) * rs) + sigm2(lo2(g11)) * bf2x(y2.z), o3 = sigm2(hi2(g01)) * (bf2x(y1.w) * rs) + sigm2(hi2(g11)) * bf2x(y2.w);
            v4u w; w.x = cvt_pk_bf16(o0[0], o0[1]); w.y = cvt_pk_bf16(o1[0], o1[1]); w.z = cvt_pk_bf16(o2[0], o2[1]); w.w = cvt_pk_bf16(o3[0], o3[1]);
            *(v4u*)(Mrg + off) = w; } }
    }
};
struct EpiRes {
    const float* srcL; const float* srcC; float* dstL; float* dstC; const float* mod;
    int gidx;
    float asc;
    __device__ __forceinline__ void operator()(const f32x4 (&acc)[2][2][4][2], const Unit& u, int wr, int wc, int fr, int fq) const {
        const bool isc = u.pm < 8;
        const int rbase = isc ? u.pm * 256 : (u.pm - 8) * 256, mrow = isc ? 8 : ((u.pm - 8) >> 4);
        const float* src = isc ? srcC : srcL; float* dst = isc ? dstC : dstL;
        const float* gate = mod + (size_t)mrow * (NMOD * D) + gidx * D;
        const int row0 = rbase + wr * 64 + fr, col0 = u.pn * 256 + wc * 32 + 8 * fq;
        f32x4 gv[2][2];
#pragma unroll
        for (int bj = 0; bj < 2; ++bj)
#pragma unroll
            for (int n = 0; n < 2; ++n) gv[bj][n] = *(const f32x4*)(gate + col0 + bj * 128 + 4 * n) * asc;
#pragma unroll
        for (int ai = 0; ai < 2; ++ai)
#pragma unroll
            for (int mh = 0; mh < 2; ++mh) {
                f32x4 sv[2][2][2];
#pragma unroll
                for (int mm = 0; mm < 2; ++mm) { const size_t off = (size_t)(row0 + ai * 128 + (2 * mh + mm) * 16) * D + col0;
#pragma unroll
                    for (int bj = 0; bj < 2; ++bj)
#pragma unroll
                        for (int n = 0; n < 2; ++n) sv[mm][bj][n] = *(const f32x4*)(src + off + bj * 128 + 4 * n); }
#pragma unroll
                for (int mm = 0; mm < 2; ++mm) { const int m = 2 * mh + mm; const size_t off = (size_t)(row0 + ai * 128 + m * 16) * D + col0;
#pragma unroll
                    for (int bj = 0; bj < 2; ++bj)
#pragma unroll
                        for (int n = 0; n < 2; ++n) *(f32x4*)(dst + off + bj * 128 + 4 * n) = sv[mm][bj][n] + gv[bj][n] * acc[ai][bj][m][n]; } }
    }
};
struct EpiSwiglu {
    bf16* H; int ldh; int pmsub;
    __device__ __forceinline__ void operator()(const f32x4 (&acc)[2][2][4][2], const Unit& u, int wr, int wc, int fr, int fq) const {
        const int row0 = (u.pm - pmsub) * 256 + wr * 64 + fr, col0 = u.pn * 128 + wc * 32 + 8 * fq;
        EPI_FOR_ROWS(ai, m) { bf16* rowp = H + (size_t)(row0 + ai * 128 + m * 16) * ldh + col0;
            const f32x4 a0 = acc[ai][0][m][0], a1 = acc[ai][0][m][1], b0 = acc[ai][1][m][0], b1 = acc[ai][1][m][1];
            const f32x2 o0 = silu2(lo2(a0)) * lo2(b0), o1 = silu2(hi2(a0)) * hi2(b0), o2 = silu2(lo2(a1)) * lo2(b1), o3 = silu2(hi2(a1)) * hi2(b1);
            v4u w; w.x = cvt_pk_bf16(o0[0], o0[1]); w.y = cvt_pk_bf16(o1[0], o1[1]); w.z = cvt_pk_bf16(o2[0], o2[1]); w.w = cvt_pk_bf16(o3[0], o3[1]);
            *(v4u*)rowp = w; }
    }
};
struct EpiSwigluS {
    bf16* H; int ldh; int pmsub; float sc;
    __device__ __forceinline__ void operator()(const f32x4 (&acc)[2][2][4][2], const Unit& u, int wr, int wc, int fr, int fq) const {
        const int row0 = (u.pm - pmsub) * 256 + wr * 64 + fr, col0 = u.pn * 128 + wc * 32 + 8 * fq;
        EPI_FOR_ROWS(ai, m) { bf16* rowp = H + (size_t)(row0 + ai * 128 + m * 16) * ldh + col0;
            const f32x4 a0 = acc[ai][0][m][0] * sc, a1 = acc[ai][0][m][1] * sc, b0 = acc[ai][1][m][0] * sc, b1 = acc[ai][1][m][1] * sc;
            const f32x2 o0 = silu2(lo2(a0)) * lo2(b0), o1 = silu2(hi2(a0)) * hi2(b0), o2 = silu2(lo2(a1)) * lo2(b1), o3 = silu2(hi2(a1)) * hi2(b1);
            v4u w; w.x = cvt_pk_bf16(o0[0], o0[1]); w.y = cvt_pk_bf16(o1[0], o1[1]); w.z = cvt_pk_bf16(o2[0], o2[1]); w.w = cvt_pk_bf16(o3[0], o3[1]);
            *(v4u*)rowp = w; }
    }
};
struct EpiSwigluF8 {
    unsigned char* H; int ldh; int pmsub; float sc;
    __device__ __forceinline__ void operator()(const f32x4 (&acc)[2][2][4][2], const Unit& u, int wr, int wc, int fr, int fq) const {
        const int row0 = (u.pm - pmsub) * 256 + wr * 64 + fr, col0 = u.pn * 128 + wc * 32 + 8 * fq;
        EPI_FOR_ROWS(ai, m) { unsigned char* rowp = H + (size_t)(row0 + ai * 128 + m * 16) * ldh + col0;
            const f32x4 a0 = acc[ai][0][m][0] * sc, a1 = acc[ai][0][m][1] * sc, b0 = acc[ai][1][m][0] * sc, b1 = acc[ai][1][m][1] * sc;
            const f32x2 o0 = silu2(lo2(a0)) * lo2(b0), o1 = silu2(hi2(a0)) * hi2(b0), o2 = silu2(lo2(a1)) * lo2(b1), o3 = silu2(hi2(a1)) * hi2(b1);
            v2u w; w.x = pk4_fp8(o0[0], o0[1], o1[0], o1[1]); w.y = pk4_fp8(o2[0], o2[1], o3[0], o3[1]);
            *(v2u*)rowp = w; }
    }
};
struct EpiMoeDown {
    bf16* YM; const float* gatew; float wsc;
    __device__ __forceinline__ void operator()(const f32x4 (&acc)[2][2][4][2], const Unit& u, int wr, int wc, int fr, int fq) const {
        const int row0 = u.pm * 256 + wr * 64 + fr, col0 = u.pn * 256 + wc * 32 + 8 * fq;
        float gwv[2][4];
        EPI_FOR_ROWS(ai, m) gwv[ai][m] = gatew[row0 + ai * 128 + m * 16];
        EPI_FOR_ROWS(ai, m) { const int row = row0 + ai * 128 + m * 16; bf16* rowp = YM + (size_t)row * D + col0; const float sc = gwv[ai][m] * wsc;
#pragma unroll
            for (int bj = 0; bj < 2; ++bj) { const f32x4 v0 = acc[ai][bj][m][0] * sc, v1 = acc[ai][bj][m][1] * sc;
                v4u w; w.x = cvt_pk_bf16(v0[0], v0[1]); w.y = cvt_pk_bf16(v0[2], v0[3]); w.z = cvt_pk_bf16(v1[0], v1[1]); w.w = cvt_pk_bf16(v1[2], v1[3]);
                *(v4u*)(rowp + bj * 128) = w; } }
    }
};
template <int NSL, int KT0, int KT1>
struct SplitKSched {
    int G, c; const char* A; const char* B; size_t tstep;
    __device__ __forceinline__ bool next(int i, Unit& u) const {
        const int L = i * G + c; if (L < 0 || L >= 32 * NSL) return false;
        const int ks = L % NSL, pn = (L / NSL) & 3, pm = L / (4 * NSL), kt0 = ks < NSL / 2 ? ks * KT0 : (NSL / 2) * KT0 + (ks - NSL / 2) * KT1;
        u.pm = pm; u.pn = pn | (ks << 2); u.A = A + (size_t)pm * tstep + kt0 * 128; u.B = B + (size_t)pn * tstep + kt0 * 128; return true;
    }
    __device__ __forceinline__ int nkt(int i) const { const int L = i * G + c; return (L % NSL) < NSL / 2 ? KT0 : KT1; }
};
struct EpiPartial {
    float* P;
    __device__ __forceinline__ void operator()(const f32x4 (&acc)[2][2][4][2], const Unit& u, int wr, int wc, int fr, int fq) const {
        const int ks = u.pn >> 2, pn = u.pn & 3, row0 = u.pm * 256 + wr * 64 + fr, col0 = pn * 256 + wc * 32 + 8 * fq;
        float* base = P + (size_t)ks * TC * D;
        EPI_FOR_ROWS(ai, m) { float* rowp = base + (size_t)(row0 + ai * 128 + m * 16) * D + col0;
#pragma unroll
            for (int bj = 0; bj < 2; ++bj) { *(f32x4*)(rowp + bj * 128) = acc[ai][bj][m][0]; *(f32x4*)(rowp + bj * 128 + 4) = acc[ai][bj][m][1]; } }
    }
};
struct EpiPartialBf {
    bf16* P;
    __device__ __forceinline__ void operator()(const f32x4 (&acc)[2][2][4][2], const Unit& u, int wr, int wc, int fr, int fq) const {
        const int ks = u.pn >> 2, pn = u.pn & 3, row0 = u.pm * 256 + wr * 64 + fr, col0 = pn * 256 + wc * 32 + 8 * fq;
        bf16* base = P + (size_t)ks * TC * D;
        EPI_FOR_ROWS(ai, m) { bf16* rowp = base + (size_t)(row0 + ai * 128 + m * 16) * D + col0;
#pragma unroll
            for (int bj = 0; bj < 2; ++bj) { const f32x4 v0 = acc[ai][bj][m][0], v1 = acc[ai][bj][m][1];
                v4u w; w.x = cvt_pk_bf16(v0[0], v0[1]); w.y = cvt_pk_bf16(v0[2], v0[3]); w.z = cvt_pk_bf16(v1[0], v1[1]); w.w = cvt_pk_bf16(v1[2], v1[3]);
                *(v4u*)(rowp + bj * 128) = w; } }
    }
};
struct MoeUpSched {
    int G, c, t0, ntg; const int* texp; const char* A; const char* B;
    __device__ __forceinline__ bool next(int i, Unit& u) const {
        const int L = i * G + c; if (L >= ntg * 28) return false;
        const int jt = t0 + L / 28, pn = L % 28; const int e = texp[jt];
        u.pm = jt; u.pn = pn; u.A = A + (size_t)(jt - t0) * 256 * D; u.B = B + ((size_t)e * (2 * FFE) + (size_t)pn * 256) * D; return true;
    }
};
struct MoeDownSched {
    int G, c, t0, ntg; const int* texp; const char* A; const char* B;
    __device__ __forceinline__ bool next(int i, Unit& u) const {
        const int L = i * G + c; if (L >= ntg * 4) return false;
        const int jt = t0 + L / 4, pn = L % 4; const int e = texp[jt];
        u.pm = jt; u.pn = pn; u.A = A + (size_t)(jt - t0) * 256 * FFE; u.B = B + ((size_t)e * D + (size_t)pn * 256) * FFE; return true;
    }
};

__device__ __forceinline__ void conv_item(const float* src  , int ldsrc, const float* kscale, bf16* dst  , int K, int k0, LAS float* scr, int lane) {
    {
        f32x4 t[8];
#pragma unroll
        for (int i = 0; i < 8; ++i) { const int kk = (lane >> 3) + 8 * i; t[i] = src ? *(const f32x4*)(src + (size_t)(k0 + kk) * ldsrc) : (f32x4){0.f, 0.f, 0.f, 0.f}; if (kscale) t[i] = t[i] * kscale[k0 + kk]; }
#pragma unroll
        for (int i = 0; i < 8; ++i) { const int kk = (lane >> 3) + 8 * i; LAS float* d = scr + kk * 33 + (lane & 7) * 4; d[0] = t[i][0]; d[1] = t[i][1]; d[2] = t[i][2]; d[3] = t[i][3]; }
    }
    LDS_WAIT(); asm volatile("" ::: "memory");
    const int c = lane & 7;
#pragma unroll
    for (int j = 0; j < 4; ++j) { const int n = (lane >> 3) + 8 * j; const LAS float* s = scr + (8 * c) * 33 + n;
        v4u o; o.x = cvt_pk_bf16(s[0 * 33], s[1 * 33]); o.y = cvt_pk_bf16(s[2 * 33], s[3 * 33]); o.z = cvt_pk_bf16(s[4 * 33], s[5 * 33]); o.w = cvt_pk_bf16(s[6 * 33], s[7 * 33]);
        *(v4u*)(dst + (size_t)n * K + k0 + 8 * c) = o; }
    LDS_WAIT(); asm volatile("" ::: "memory");
}
__device__ __forceinline__ int win_src_col(int n) {
    if (n < 3072) return C_XBC + n;
    if (n < WIN_B) return (n < 3072 + 64) ? C_DT + (n - 3072) : -1;
    n -= WIN_B;
    if (n < 4096) {
        const int t = n >> 8, c = n & 255, bj = c >> 7, wc = (c >> 5) & 3, fq = (c >> 3) & 3, nn = (c >> 2) & 1, j = c & 3, ch = 64 * t + 16 * wc + 4 * fq + j;
        return (bj == 0 ? (nn == 0 ? C_GC : C_HV) : (nn == 0 ? C_GB : C_Z)) + ch; }
    if (n < 5120) return C_Z + 1024 + (n - 4096);
    n -= 5120;
    { const int q = n >> 8, r = n & 255; return r < 128 ? C_G0 + 128 * q + r : C_G1 + 128 * q + (r - 128); }
}
template <class FSRC>
__device__ __forceinline__ void conv_job(const FSRC& fsrc, const float* kscale, bf16* dst, int K, int ngroups, LAS float* scr, int gw, int NGW, int lane) {
    const int kb_n = K / 64, items = kb_n * ngroups, ipw = (items + NGW - 1) / NGW;
    for (int it = gw * ipw; it < items && it < (gw + 1) * ipw; ++it) { const int nb = it / kb_n, kb = it % kb_n; int ld; const float* src = fsrc(nb * 32 + (lane & 7) * 4, ld);
        conv_item(src, ld, kscale, dst + (size_t)nb * 32 * K, K, kb * 64, scr, lane); }
}

__device__ __forceinline__ void conv_item_f8(const float* src, int ldsrc, float wscale, unsigned char* dst  , int K, int k0, LAS float* scr, int lane) {
    { f32x4 t[8];
#pragma unroll
      for (int i = 0; i < 8; ++i) { const int kk = (lane >> 3) + 8 * i; t[i] = *(const f32x4*)(src + (size_t)(k0 + kk) * ldsrc) * wscale; }
#pragma unroll
      for (int i = 0; i < 8; ++i) { const int kk = (lane >> 3) + 8 * i; LAS float* d = scr + kk * 33 + (lane & 7) * 4; d[0] = t[i][0]; d[1] = t[i][1]; d[2] = t[i][2]; d[3] = t[i][3]; } }
    LDS_WAIT(); asm volatile("" ::: "memory");
    const int n = lane & 31, hf = lane >> 5; const LAS float* sp = scr + (32 * hf) * 33 + n;
    v4u o0, o1;
    o0.x = pk4_fp8(sp[0 * 33], sp[1 * 33], sp[2 * 33], sp[3 * 33]); o0.y = pk4_fp8(sp[4 * 33], sp[5 * 33], sp[6 * 33], sp[7 * 33]); o0.z = pk4_fp8(sp[8 * 33], sp[9 * 33], sp[10 * 33], sp[11 * 33]); o0.w = pk4_fp8(sp[12 * 33], sp[13 * 33], sp[14 * 33], sp[15 * 33]);
    o1.x = pk4_fp8(sp[16 * 33], sp[17 * 33], sp[18 * 33], sp[19 * 33]); o1.y = pk4_fp8(sp[20 * 33], sp[21 * 33], sp[22 * 33], sp[23 * 33]); o1.z = pk4_fp8(sp[24 * 33], sp[25 * 33], sp[26 * 33], sp[27 * 33]); o1.w = pk4_fp8(sp[28 * 33], sp[29 * 33], sp[30 * 33], sp[31 * 33]);
    unsigned char* dp = dst + (size_t)n * K + k0 + 32 * hf;
    *(v4u*)dp = o0; *(v4u*)(dp + 16) = o1;
    LDS_WAIT(); asm volatile("" ::: "memory");
}
template <class FSRC>
__device__ __forceinline__ void conv_job_f8(const FSRC& fsrc, float wscale, unsigned char* dst, int K, int ngroups, LAS float* scr, int gw, int NGW, int lane) {
    const int kb_n = K / 64, items = kb_n * ngroups, ipw = (items + NGW - 1) / NGW;
    for (int it = gw * ipw; it < items && it < (gw + 1) * ipw; ++it) { const int nb = it / kb_n, kb = it % kb_n; int ld; const float* src = fsrc(nb * 32 + (lane & 7) * 4, ld);
        conv_item_f8(src, ld, wscale, dst + (size_t)nb * 32 * K, K, kb * 64, scr, lane); }
}

struct TileDesc { const float* src; int ld; unsigned char* dst; int dk; float sc; };
template <class FD>
__device__ __forceinline__ void conv_tiles_f8(const FD desc, int t0, int t1, LAS unsigned char* lds, int tid) {
    const int wv = __builtin_amdgcn_readfirstlane(tid >> 6), lrow = tid >> 5, lg = tid & 31, n = tid & 127, kq = tid >> 7;
#define CT_ISSUE(t, buf) do { const TileDesc _td = desc(t); \
        _Pragma("unroll") for (int _r = 0; _r < 8; ++_r) __builtin_amdgcn_global_load_lds((const unsigned*)(_td.src + (size_t)(16 * _r + lrow) * _td.ld + 4 * lg), (LAS unsigned*)(lds + (buf) * 65536 + (16 * _r + 2 * wv) * 512), 16, 0, 0); } while (0)
    if (t0 >= t1) return;
    CT_ISSUE(t0, 0);
    for (int t = t0; t < t1; ++t) { const int buf = (t - t0) & 1;
        if (t + 1 < t1) { CT_ISSUE(t + 1, buf ^ 1); asm volatile("s_waitcnt vmcnt(8)" ::: "memory"); } else asm volatile("s_waitcnt vmcnt(0)" ::: "memory");
        __syncthreads();
        const TileDesc td = desc(t);
        const LAS float* col = (const LAS float*)(lds + buf * 65536) + (32 * kq) * 128 + n;
        float f[32];
#pragma unroll
        for (int i = 0; i < 32; ++i) f[i] = col[i * 128] * td.sc;
        v4u o0, o1;
        o0.x = pk4_fp8(f[0], f[1], f[2], f[3]); o0.y = pk4_fp8(f[4], f[5], f[6], f[7]); o0.z = pk4_fp8(f[8], f[9], f[10], f[11]); o0.w = pk4_fp8(f[12], f[13], f[14], f[15]);
        o1.x = pk4_fp8(f[16], f[17], f[18], f[19]); o1.y = pk4_fp8(f[20], f[21], f[22], f[23]); o1.z = pk4_fp8(f[24], f[25], f[26], f[27]); o1.w = pk4_fp8(f[28], f[29], f[30], f[31]);
        unsigned char* dp = td.dst + (size_t)n * td.dk + 32 * kq;
        *(v4u*)dp = o0; *(v4u*)(dp + 16) = o1;
        __syncthreads();
    }
#undef CT_ISSUE
}

__global__ void __launch_bounds__(NTHR, 2) mk_fwd(Args args) {
    extern __shared__ __attribute__((aligned(16))) unsigned char ldsraw[];
    LAS unsigned char* lds = (LAS unsigned char*)ldsraw;
    volatile LAS unsigned* MISC = (volatile LAS unsigned*)(lds + MISC_OFF);
    const int tid0 = threadIdx.x;
    const int G0 = gridDim.x, bid0 = blockIdx.x;
    unsigned char* ws0 = args.ws;
    for (int u = tid0; u < (LDS_BYTES - 131072) / 4; u += NTHR) ((LAS unsigned*)(lds + 131072))[u] = 0u;
    __syncthreads();
    XcdBarrier bar = xcd_barrier_post((unsigned*)(ws0 + WS_CTL) + CW_BAR, MISC + 8);
    (void)bar;
#define GRID_BAR() do { const __attribute__((address_space(4))) char* kpb_ = (const __attribute__((address_space(4))) char*)__builtin_amdgcn_kernarg_segment_ptr(); asm volatile("" : "+s"(kpb_)); \
        XcdBarrier bb_; bb_.bar = (unsigned*)(*(unsigned char* const __attribute__((address_space(4)))*)(kpb_ + 8 * 29) + WS_CTL) + CW_BAR; bb_.x = xb_xcc_id(); bb_.st = MISC + 8; xcd_barrier(bb_); } while (0)
#define CAS __attribute__((address_space(4)))
#define PHASE_BEGIN int tid = tid0; asm volatile("" : "+v"(tid)); int G = G0, bid = bid0; asm volatile("" : "+s"(G), "+s"(bid)); const CAS char* kp = (const CAS char*)__builtin_amdgcn_kernarg_segment_ptr(); asm volatile("" : "+s"(kp)); \
    unsigned char* ws = (unsigned char*)(*(unsigned char* const CAS*)(kp + 8 * 29)); float* OUT = (float*)(*(float* const CAS*)(kp + 8 * 28)); (void)OUT; \
    const int lane = tid & 63, wave = __builtin_amdgcn_readfirstlane(tid >> 6), gw = bid * NWAVES + wave, NGW = G * NWAVES; (void)lane; (void)gw; (void)NGW; (void)ws
#define AIN(k) (*(const float* const CAS*)(kp + 8 * (k)))
#define MOD  ((float*)(ws + WS_MOD))
#define RSS  ((float*)(ws + WS_RSS))
#define DTB  ((float*)(ws + WS_DT))
#define CTXS ((float*)(ws + WS_CTXS))
#define HB   ((bf16*)(ws + WS_HB))
#define XBC  ((bf16*)(ws + WS_XBC))
#define XBCC ((bf16*)(ws + WS_XBCC))
#define Yb   ((bf16*)(ws + WS_Y))
#define Ub   ((bf16*)(ws + WS_U))
#define GBb  ((bf16*)(ws + WS_GB))
#define Vb   ((bf16*)(ws + WS_V))
#define Y1b  ((bf16*)(ws + WS_Y1))
#define Y2b  ((bf16*)(ws + WS_Y2))
#define MRG  ((bf16*)(ws + WS_MRG))
#define HF   ((bf16*)(ws + WS_HF))
#define PY1  ((bf16*)(ws + WS_ACS))
#define DPART ((float*)(ws + WS_R1))
#define MODL (MOD + (size_t)l * 9 * (NMOD * D))
#define XSRCL ((l == 0) ? AIN(I_X) : (const float*)OUT)
#define XSRCC ((l == 0) ? AIN(I_CTX) : (const float*)CTXS)
#define WINT ((const bf16*)(ws + WS_WIN + l * WIN_STRIDE))

#if PH(0)
    { PHASE_BEGIN;
        LAS float* scr = (LAS float*)(lds + wave * 16384);
        for (int l = 0; l < DEPTH; ++l) {
            const float* win = AIN(I_WIN) + (size_t)l * D * INW;
            conv_job([&](int n, int& ld) -> const float* { ld = INW; const int c = win_src_col(n); return c < 0 ? nullptr : win + c; }, nullptr, (bf16*)(ws + WS_WIN + l * WIN_STRIDE), D, WIN_ROWS / 32, scr, gw, NGW, lane);
            const float* wssd = AIN(I_WSSD) + (size_t)l * SSDI * D;
            conv_job([&](int n, int& ld) -> const float* { ld = D; return wssd + n; }, AIN(I_SNG) + l * SSDI, (bf16*)(ws + WS_WSSD + l * WSSD_STRIDE), SSDI, D / 32, scr, gw, NGW, lane);
            const float* wsc = AIN(I_WSC) + (size_t)l * D * D;
            conv_job([&](int n, int& ld) -> const float* { ld = D; return wsc + n; }, nullptr, (bf16*)(ws + WS_WSC + l * WSC_STRIDE), D, D / 32, scr, gw, NGW, lane);
            const float* wo = AIN(I_WO) + (size_t)l * D * D;
            conv_job([&](int n, int& ld) -> const float* { ld = D; return wo + n; }, nullptr, (bf16*)(ws + WS_WO + l * WO_STRIDE), D, D / 32, scr, gw, NGW, lane);
        }
        { const float* f1 = AIN(I_F1); const float* f3 = AIN(I_F3);
#if FFN_F8 & 1
          conv_job_f8([&](int n, int& ld) -> const float* { ld = FFD; const int q = n >> 8, r = n & 255; return r < 128 ? f1 + 128 * q + r : f3 + 128 * q + (r - 128); }, MOE_WS1, ws + WS_W13, D, 2 * FFD / 32, scr, gw, NGW, lane);
#else
          conv_job([&](int n, int& ld) -> const float* { ld = FFD; const int q = n >> 8, r = n & 255; return r < 128 ? f1 + 128 * q + r : f3 + 128 * q + (r - 128); }, nullptr, (bf16*)(ws + WS_W13), D, 2 * FFD / 32, scr, gw, NGW, lane);
#endif
          const float* f2 = AIN(I_F2);
#if FFN_F8 & 2
          conv_job_f8([&](int n, int& ld) -> const float* { ld = D; return f2 + n; }, MOE_WS2, ws + WS_W2, FFD, D / 32, scr, gw, NGW, lane); }
#else
          conv_job([&](int n, int& ld) -> const float* { ld = D; return f2 + n; }, nullptr, (bf16*)(ws + WS_W2), FFD, D / 32, scr, gw, NGW, lane); }
#endif
        __syncthreads();
        LAS float* sc = (LAS float*)lds;
        LAS float* red = (LAS float*)(lds + 40960);
        bool loaded = false;
        for (int it = bid; it < DEPTH * (NMOD * D / 64); it += G) {
            if (!loaded) { for (int i = tid; i < 9 * D; i += NTHR) { const float v = i < 8 * D ? AIN(I_C)[i] : AIN(I_CCTX)[i - 8 * D]; sc[i] = siluf(v); } loaded = true; }
            __syncthreads();
            const int l = it / (NMOD * D / 64), j0 = (it % (NMOD * D / 64)) * 64, kq = tid >> 6, jj = tid & 63;
            const float* w = AIN(I_WMOD) + (size_t)l * D * (NMOD * D) + j0 + jj;
            float a[9];
#pragma unroll
            for (int r = 0; r < 9; ++r) a[r] = 0.f;
#pragma unroll 8
            for (int k = kq * 128; k < kq * 128 + 128; ++k) { const float wv = w[(size_t)k * (NMOD * D)];
#pragma unroll
                for (int r = 0; r < 9; ++r) a[r] += sc[r * D + k] * wv; }
#pragma unroll
            for (int r = 0; r < 9; ++r) red[(kq * 9 + r) * 64 + jj] = a[r];
            __syncthreads();
            for (int o = tid; o < 9 * 64; o += NTHR) { const int r = o >> 6, j = o & 63; float s = AIN(I_BMOD)[(size_t)l * (NMOD * D) + j0 + j];
#pragma unroll
                for (int q = 0; q < 8; ++q) s += red[(q * 9 + r) * 64 + j];
                MOD[((size_t)l * 9 + r) * (NMOD * D) + j0 + j] = s; }
            __syncthreads();
        }
    }
#endif
    GRID_BAR();

    for (int l = 0; l < DEPTH; ++l) {
        const bool lastl = (l == DEPTH - 1);

#if PH(1)
        { PHASE_BEGIN;
            const float* g = AIN(I_N1G) + l * D;
            for (int r = gw; r < MR; r += NGW) {
                const bool isc = r < TC; const int rr = isc ? r : r - TC; const int mrow = isc ? 8 : (rr >> 12);
                const f32x4* xr = (const f32x4*)((isc ? XSRCC : XSRCL) + (size_t)rr * D) + lane;
                const float* mv = MODL + (size_t)mrow * (NMOD * D);
                f32x4 v[4]; float ss = 0.f;
#pragma unroll
                for (int j = 0; j < 4; ++j) v[j] = xr[64 * j];
                if (l > 0 && isc) {
                    const f32x4* pp = (const f32x4*)(DPART + (size_t)rr * D) + lane; const f32x4* gt = (const f32x4*)(MOD + ((size_t)(l - 1) * 9 + 8) * (NMOD * D) + 5 * D) + lane;
#pragma unroll
                    for (int j = 0; j < 4; ++j) { const f32x4 p = (pp[64 * j] + pp[(size_t)TC * D / 4 + 64 * j]) + (pp[(size_t)2 * TC * D / 4 + 64 * j] + pp[(size_t)3 * TC * D / 4 + 64 * j]); v[j] += gt[64 * j] * p; } }
#pragma unroll
                for (int j = 0; j < 4; ++j) ss += (v[j][0] * v[j][0] + v[j][1] * v[j][1]) + (v[j][2] * v[j][2] + v[j][3] * v[j][3]);
                const float rstd = rsqrtf(wave_sum(ss) * (1.0f / D) + EPS);
                v2u* o8 = (v2u*)(HB + (size_t)r * D) + lane;
#pragma unroll
                for (int j = 0; j < 4; ++j) { const f32x4 gv = ((const f32x4*)g)[64 * j + lane], sh = ((const f32x4*)(mv + 0 * D))[64 * j + lane], scl = ((const f32x4*)(mv + 1 * D))[64 * j + lane];
                    const f32x4 y = v[j] * rstd * gv * (scl + 1.0f) + sh; v2u w; w.x = cvt_pk_bf16(y[0], y[1]); w.y = cvt_pk_bf16(y[2], y[3]); o8[64 * j] = w; }
            }
        }
#endif
        GRID_BAR();

#if PH(2)
        { PHASE_BEGIN;
            pg8::GridSched S; S.init(MR / 256, WIN_A_N / 256, 0, G, bid, HB, WINT + (size_t)WIN_A * D, 2 * D);
            EpiXbcConv E{XBCC, DTB, AIN(I_DTB) + l * 64, AIN(I_SCW) + (size_t)l * 3 * XBCW, AIN(I_SCB) + (size_t)l * XBCW, (float*)(ws + WS_XBC), (LAS float*)(lds + 136192)};
            pg8::gemm_phase<EpiXbcConv, pg8::GridSched>(lds, 2 * D, S, E);
        }
#endif
        GRID_BAR();

#if PH(3)
        { PHASE_BEGIN;
            const float* cw = AIN(I_SCW) + (size_t)l * 3 * XBCW; const float* cb = AIN(I_SCB) + (size_t)l * XBCW;
            { const float* RB = (const float*)(ws + WS_XBC);
              const int NG8 = XBCW / 8;
              for (int it = bid * NTHR + tid; it < 128 * 2 * NG8; it += G * NTHR) {
                  const int c8 = (it % NG8) * 8, rsel = (it / NG8) & 1, pm = 8 + it / (2 * NG8);
                  if (((pm - 8) & 15) == 0) continue;
                  const float* ra = rsel == 0 ? RB + ((size_t)((pm - 1) * 4 + 2) * XBCW + c8) : RB + ((size_t)((pm - 1) * 4 + 3) * XBCW + c8);
                  const float* rb_ = rsel == 0 ? RB + ((size_t)((pm - 1) * 4 + 3) * XBCW + c8) : RB + ((size_t)(pm * 4 + 0) * XBCW + c8);
                  const float* rc = rsel == 0 ? RB + ((size_t)(pm * 4 + 0) * XBCW + c8) : RB + ((size_t)(pm * 4 + 1) * XBCW + c8);
                  float o[8];
#pragma unroll
                  for (int q = 0; q < 2; ++q) { const f32x4 a = *(const f32x4*)(ra + 4 * q), b = *(const f32x4*)(rb_ + 4 * q), c = *(const f32x4*)(rc + 4 * q);
                      const f32x4 w0 = *(const f32x4*)(cw + c8 + 4 * q), w1 = *(const f32x4*)(cw + XBCW + c8 + 4 * q), w2 = *(const f32x4*)(cw + 2 * XBCW + c8 + 4 * q), bb = *(const f32x4*)(cb + c8 + 4 * q);
#pragma unroll
                      for (int e = 0; e < 4; ++e) o[4 * q + e] = siluf(w0[e] * a[e] + w1[e] * b[e] + w2[e] * c[e] + bb[e]); }
                  const int r = rsel == 0 ? pm * 256 - 1 : pm * 256, chk = r >> 6, ri = r & 63; bf16* dstp;
                  if (c8 < 2048) dstp = XBCC + ((size_t)(chk * 32 + (c8 >> 6)) * 4096 + ri * 64 + (c8 & 63));
                  else if (c8 < 2560) dstp = XBCC + XS_ELEMS + ((size_t)(chk * 4 + ((c8 - 2048) >> 7)) * 8192 + ri * 128 + ((c8 - 2048) & 127));
                  else dstp = XBCC + XS_ELEMS + BS_ELEMS + ((size_t)(chk * 4 + ((c8 - 2560) >> 7)) * 8192 + ri * 128 + ((c8 - 2560) & 127));
                  v4u w; w.x = cvt_pk_bf16(o[0], o[1]); w.y = cvt_pk_bf16(o[2], o[3]); w.z = cvt_pk_bf16(o[4], o[5]); w.w = cvt_pk_bf16(o[6], o[7]);
                  *(v4u*)dstp = w; } }
            { float* ACSo = (float*)(ws + WS_ACS); float* WWo = (float*)(ws + WS_WW); float* EAo = (float*)(ws + WS_EA);
              const float av = -__expf(AIN(I_ALOG)[l * 64 + lane]);
              for (int ch = gw; ch < MR / 64; ch += NGW) { const float* dp = DTB + (size_t)ch * 64 * 64 + lane;
                  float dtr[64]; float tot = 0.f;
#pragma unroll
                  for (int i = 0; i < 64; ++i) dtr[i] = dp[i * 64];
#pragma unroll
                  for (int i = 0; i < 64; ++i) tot += dtr[i] * av;
                  float P = 0.f;
#pragma unroll
                  for (int i = 0; i < 64; ++i) { const float dt = dtr[i], da = dt * av; P += da; const float acs = (lane >= 32) ? (tot - P + da) : P;
                      ACSo[(size_t)ch * 4096 + i * 64 + lane] = acs; WWo[(size_t)ch * 4096 + i * 64 + lane] = dt * __expf(tot - acs); }
                  EAo[ch * 64 + lane] = __expf(tot); } }
        }
#endif
        GRID_BAR();

#if PH(4)
        { PHASE_BEGIN;
#define SC_BAR() do { asm volatile("s_waitcnt lgkmcnt(0)" ::: "memory"); __builtin_amdgcn_s_barrier(); asm volatile("" ::: "memory"); } while (0)
            constexpr int LDK = 136, LDX = 72;
            const int dir = wave >> 2, cw = wave & 3, ctid = tid & 255;
            LAS unsigned char* cb = lds + dir * 65536;
            LAS bf16* Bn = (LAS bf16*)(cb); LAS bf16* Cn = (LAS bf16*)(cb + 17408); LAS bf16* Xn = (LAS bf16*)(cb + 34816); LAS bf16* Xw = (LAS bf16*)(cb + 44032); LAS bf16* GL = (LAS bf16*)(cb + 53248);
            LAS float* tab = (LAS float*)(lds + 132096 + wave * 512);
            LAS unsigned char* YS = lds + 136192 + dir * 9216;
            const int fr = lane & 15, fq = lane >> 4;
            typedef short s4v __attribute__((ext_vector_type(4)));
            const float* ACSg = (const float*)(ws + WS_ACS); const float* WWg = (const float*)(ws + WS_WW); const float* EAg = (const float*)(ws + WS_EA);
#define SC_TRP(M, ld, s0, col0) ((M) + ((s0) + (fr >> 2)) * (ld) + (col0) + 4 * (fr & 3))
#define SC_TRLO(p) __builtin_amdgcn_ds_read_tr16_b64_v4i16((LAS s4v*)(p))
#define SC_CAT(lo, hi) ((bf16x8){lo[0], lo[1], lo[2], lo[3], hi[0], hi[1], hi[2], hi[3]})
            for (int unit = bid; unit < NB * NHEAD; unit += G) {
                const int pi_ = (unit & 7) * 4 + ((unit >> 3) >> 3), b = pi_ >> 2, grp = pi_ & 3, h = grp * 8 + ((unit >> 3) & 7);
                const float Dsk = AIN(I_SSDD)[l * NHEAD + h];
                const int col = dir * 32 + h;
                f32x4 st[8];
#pragma unroll
                for (int q = 0; q < 8; ++q) st[q] = (f32x4){0.f, 0.f, 0.f, 0.f};
                v4u rC[4], rB[4], rX[2]; float racs, rdt, rw[2], rea;
#define SC_ROW0(j) ((j) < 4 ? b * 256 + 64 * (dir ? 3 - (j) : (j)) : TC + b * 4096 + 64 * (dir ? 63 - ((j) - 4) : (j) - 4))
#define SC_LOAD_B(j) do { const int _r0 = SC_ROW0(j), _ck = _r0 >> 6; const bf16* _pb = XBCC + XS_ELEMS + (size_t)(_ck * 4 + grp) * 8192; \
                    _Pragma("unroll") for (int _i = 0; _i < 4; ++_i) { const int _q = ctid + 256 * _i; rB[_i] = *(const v4u*)(_pb + _q * 8); } } while (0)
#define SC_LOAD_C(j) do { const int _r0 = SC_ROW0(j), _ck = _r0 >> 6; const bf16* _pc = XBCC + XS_ELEMS + BS_ELEMS + (size_t)(_ck * 4 + grp) * 8192; \
                    _Pragma("unroll") for (int _i = 0; _i < 4; ++_i) { const int _q = ctid + 256 * _i; rC[_i] = *(const v4u*)(_pc + _q * 8); } } while (0)
#define SC_LOAD_X(j) do { const int _r0 = SC_ROW0(j), _ck = _r0 >> 6; const bf16* _px = XBCC + (size_t)(_ck * 32 + h) * 4096; \
                    const float* _pw = WWg + ((size_t)_r0 * 64 + col); const float* _pa = ACSg + ((size_t)_r0 * 64 + col); const float* _pd = DTB + ((size_t)_r0 * 64 + col);        \
                    _Pragma("unroll") for (int _i = 0; _i < 2; ++_i) { const int _q = ctid + 256 * _i, _row = _q >> 3; rX[_i] = *(const v4u*)(_px + _q * 8); rw[_i] = _pw[_row * 64]; } \
                    racs = _pa[lane * 64]; rdt = _pd[lane * 64]; rea = EAg[(size_t)_ck * 64 + col]; } while (0)
#define SC_LOAD(j) do { SC_LOAD_B(j); SC_LOAD_C(j); SC_LOAD_X(j); } while (0)
                SC_LOAD(0);
                v4u yo[2];
                yo[0] = (v4u){0u, 0u, 0u, 0u}; yo[1] = yo[0];
#define SC_YADDR(pj, i) ((Yb + ((size_t)(SC_ROW0(pj) + 16 * cw) * SSDI + 64 * h)) + ((8 * (i) + (lane >> 3)) * SSDI + 8 * (lane & 7)))
#define SC_FLUSH(pj) do { if (!(lastl && (pj) < 4)) { const bool _first = ((pj) < 4) ? ((pj) <= 1) : ((pj) <= 35); \
                    if (!_first && ((pj) == 2 || (pj) == 36)) { _Pragma("unroll") for (int _i = 0; _i < 2; ++_i) yo[_i] = *(const v4u*)SC_YADDR(pj, _i); } \
                    _Pragma("unroll") for (int _i = 0; _i < 2; ++_i) { v4u _y = *(const LAS v4u*)(YS + (16 * cw + 8 * _i + (lane >> 3)) * 144 + 16 * (lane & 7)); \
                        if (!_first) { const v4u _o = yo[_i]; \
                            _y.x = cvt_pk_bf16(bflo(_y.x) + bflo(_o.x), bfhi(_y.x) + bfhi(_o.x)); _y.y = cvt_pk_bf16(bflo(_y.y) + bflo(_o.y), bfhi(_y.y) + bfhi(_o.y)); \
                            _y.z = cvt_pk_bf16(bflo(_y.z) + bflo(_o.z), bfhi(_y.z) + bfhi(_o.z)); _y.w = cvt_pk_bf16(bflo(_y.w) + bflo(_o.w), bfhi(_y.w) + bfhi(_o.w)); } \
                        *(v4u*)SC_YADDR(pj, _i) = _y; } } } while (0)
                for (int j = 0; j < 68; ++j) {
                    const int jn = j < 67 ? j + 1 : 67;
                    if (j > 0) SC_FLUSH(j - 1);
                    const float eA = rea;
                    tab[lane] = racs; tab[64 + lane] = rdt;
#pragma unroll
                    for (int i = 0; i < 4; ++i) { const int q = ctid + 256 * i, row = q >> 4, c = (q & 15) * 8; *(LAS v4u*)(Bn + row * LDK + c) = rB[i]; *(LAS v4u*)(Cn + row * LDK + c) = rC[i]; }
#pragma unroll
                    for (int i = 0; i < 2; ++i) { const int q = ctid + 256 * i, row = q >> 3, c = (q & 7) * 8; *(LAS v4u*)(Xn + row * LDX + c) = rX[i];
                        const float wr_ = rw[i]; v4u xs;
                        xs.x = cvt_pk_bf16(bflo(rX[i].x) * wr_, bfhi(rX[i].x) * wr_); xs.y = cvt_pk_bf16(bflo(rX[i].y) * wr_, bfhi(rX[i].y) * wr_);
                        xs.z = cvt_pk_bf16(bflo(rX[i].z) * wr_, bfhi(rX[i].z) * wr_); xs.w = cvt_pk_bf16(bflo(rX[i].w) * wr_, bfhi(rX[i].w) * wr_);
                        *(LAS v4u*)(Xw + row * LDX + c) = xs; }
                    SC_BAR();
                    const bool wr_y = !(lastl && j < 4);
                    const bool first = (j < 4) ? (j <= 1) : (j <= 35);
                    if (wr_y && !first && j != 2 && j != 36) {
#pragma unroll
                        for (int i = 0; i < 2; ++i) yo[i] = *(const v4u*)SC_YADDR(j, i); }
                    SC_LOAD_B(jn);
                    {
                        bf16x8 cf[4], bfr[4][4];
#pragma unroll
                        for (int ks = 0; ks < 4; ++ks) { cf[ks] = *(const LAS bf16x8*)(Cn + (16 * cw + fr) * LDK + 32 * ks + 8 * fq);
#pragma unroll
                            for (int q = 0; q < 4; ++q) bfr[q][ks] = *(const LAS bf16x8*)(Bn + (16 * q + fr) * LDK + 32 * ks + 8 * fq); }
                        __builtin_amdgcn_sched_barrier(0);
                        SC_LOAD_C(jn);
                        __builtin_amdgcn_sched_barrier(0);
                        f32x4 g[4];
#pragma unroll
                        for (int q = 0; q < 4; ++q) g[q] = (f32x4){0.f, 0.f, 0.f, 0.f};
#pragma unroll
                        for (int ks = 0; ks < 4; ++ks)
#pragma unroll
                            for (int q = 0; q < 4; ++q) g[q] = __builtin_amdgcn_mfma_f32_16x16x32_bf16(bfr[q][ks], cf[ks], g[q], 0, 0, 0);
                        const int lrow = 16 * cw + fr; const float acs_l = tab[lrow];
                        f32x4 as4[4], dt4[4];
#pragma unroll
                        for (int q = 0; q < 4; ++q) { as4[q] = *(const LAS f32x4*)(tab + 16 * q + 4 * fq); dt4[q] = *(const LAS f32x4*)(tab + 64 + 16 * q + 4 * fq); }
#pragma unroll
                        for (int q = 0; q < 4; ++q) { float o[4];
#pragma unroll
                            for (int r = 0; r < 4; ++r) { const int s = 16 * q + 4 * fq + r; const bool ok = dir ? (s >= lrow) : (s <= lrow); o[r] = g[q][r] * __expf(fminf(acs_l - as4[q][r], 0.f)) * (ok ? dt4[q][r] : 0.f); }
                            v2u w; w.x = cvt_pk_bf16(o[0], o[1]); w.y = cvt_pk_bf16(o[2], o[3]);
                            *(LAS v2u*)(GL + lrow * LDX + 16 * q + 4 * fq) = w; }
                    }
                    SC_BAR();
                    {
                        s4v xlo[2], xhi[2];
#pragma unroll
                        for (int ks = 0; ks < 2; ++ks) { const LAS bf16* p_ = SC_TRP(Xn, LDX, 32 * ks + 8 * fq, 16 * cw); xlo[ks] = SC_TRLO(p_); xhi[ks] = SC_TRLO(p_ + 4 * LDX); }
                        bf16x8 sa[4];
#pragma unroll
                        for (int q = 0; q < 4; ++q) { const unsigned w0 = cvt_pk_bf16(st[2 * q][0], st[2 * q][1]), w1 = cvt_pk_bf16(st[2 * q][2], st[2 * q][3]), w2 = cvt_pk_bf16(st[2 * q + 1][0], st[2 * q + 1][1]), w3 = cvt_pk_bf16(st[2 * q + 1][2], st[2 * q + 1][3]);
                            const v4u pk = (v4u){w0, w1, w2, w3}; sa[q] = __builtin_bit_cast(bf16x8, pk); }
                        __builtin_amdgcn_sched_barrier(0);
                        SC_LOAD_X(jn);
                        __builtin_amdgcn_sched_barrier(0);
#pragma unroll
                        for (int lh = 0; lh < 2; ++lh) {
                            bf16x8 glf[2][2]; v2u c0[2][4], c1[2][4]; float tl[2]; v2u xsk[2];
#pragma unroll
                            for (int t2 = 0; t2 < 2; ++t2) { const int lrow = 16 * (2 * lh + t2) + fr;
#pragma unroll
                                for (int ks = 0; ks < 2; ++ks) glf[t2][ks] = *(const LAS bf16x8*)(GL + lrow * LDX + 32 * ks + 8 * fq);
#pragma unroll
                                for (int q = 0; q < 4; ++q) { c0[t2][q] = *(const LAS v2u*)(Cn + lrow * LDK + 32 * q + 4 * fq); c1[t2][q] = *(const LAS v2u*)(Cn + lrow * LDK + 32 * q + 16 + 4 * fq); }
                                tl[t2] = tab[lrow]; xsk[t2] = *(const LAS v2u*)(Xn + lrow * LDX + 16 * cw + 4 * fq); }
                            __builtin_amdgcn_sched_barrier(0);
                            f32x4 a2[2], a3[2];
#pragma unroll
                            for (int t2 = 0; t2 < 2; ++t2) { a2[t2] = (f32x4){0.f, 0.f, 0.f, 0.f}; a3[t2] = (f32x4){0.f, 0.f, 0.f, 0.f}; }
#pragma unroll
                            for (int ks = 0; ks < 2; ++ks) { const bf16x8 xa = SC_CAT(xlo[ks], xhi[ks]);
#pragma unroll
                                for (int t2 = 0; t2 < 2; ++t2) a2[t2] = __builtin_amdgcn_mfma_f32_16x16x32_bf16(xa, glf[t2][ks], a2[t2], 0, 0, 0); }
#pragma unroll
                            for (int q = 0; q < 4; ++q)
#pragma unroll
                                for (int t2 = 0; t2 < 2; ++t2) { const v4u pk = (v4u){c0[t2][q].x, c0[t2][q].y, c1[t2][q].x, c1[t2][q].y}; a3[t2] = __builtin_amdgcn_mfma_f32_16x16x32_bf16(sa[q], __builtin_bit_cast(bf16x8, pk), a3[t2], 0, 0, 0); }
                            if (wr_y) {
#pragma unroll
                                for (int t2 = 0; t2 < 2; ++t2) { const int lt = 2 * lh + t2, lrow = 16 * lt + fr; const float el = __expf(tl[t2]); f32x4 yv = a2[t2] + a3[t2] * el;
                                    if (dir) { const v2u xv = xsk[t2]; yv[0] += Dsk * bflo(xv.x); yv[1] += Dsk * bfhi(xv.x); yv[2] += Dsk * bflo(xv.y); yv[3] += Dsk * bfhi(xv.y); }
                                    v2u w; w.x = cvt_pk_bf16(yv[0], yv[1]); w.y = cvt_pk_bf16(yv[2], yv[3]); *(LAS v2u*)(YS + lrow * 144 + 2 * (16 * cw + 4 * fq)) = w; } }
                        }
                        s4v wlo[2], whi[2], blo[8][2], bhi[8][2];
#pragma unroll
                        for (int ks = 0; ks < 2; ++ks) { const LAS bf16* p_ = SC_TRP(Xw, LDX, 32 * ks + 8 * fq, 16 * cw); wlo[ks] = SC_TRLO(p_); whi[ks] = SC_TRLO(p_ + 4 * LDX);
#pragma unroll
                            for (int q = 0; q < 8; ++q) { const LAS bf16* pb_ = SC_TRP(Bn, LDK, 32 * ks + 8 * fq, 16 * q); blo[q][ks] = SC_TRLO(pb_); bhi[q][ks] = SC_TRLO(pb_ + 4 * LDK); } }
                        __builtin_amdgcn_sched_barrier(0);
#pragma unroll
                        for (int q = 0; q < 8; ++q) st[q] = st[q] * eA;
#pragma unroll
                        for (int ks = 0; ks < 2; ++ks) { const bf16x8 xb = SC_CAT(wlo[ks], whi[ks]);
#pragma unroll
                            for (int q = 0; q < 8; ++q) st[q] = __builtin_amdgcn_mfma_f32_16x16x32_bf16(SC_CAT(blo[q][ks], bhi[q][ks]), xb, st[q], 0, 0, 0); }
                    }
                    if (j == 36 || j == 2) VM_WAIT();
                    SC_BAR();
                }
                LDS_WAIT(); SC_FLUSH(67);
                __syncthreads();
#undef SC_LOAD
#undef SC_FLUSH
#undef SC_YADDR
#undef SC_LOAD_B
#undef SC_LOAD_C
#undef SC_LOAD_X
#undef SC_ROW0
            }
#undef SC_TRP
#undef SC_TRLO
#undef SC_CAT
        }
#endif
        GRID_BAR();

        const int pm0 = lastl ? 8 : 0, nMt = lastl ? T / 256 : MR / 256;
#if PH(5)
        { PHASE_BEGIN;
            pg8::GridSched S; S.init(nMt, WIN_B_N / 256, pm0, G, bid, HB, WINT + (size_t)WIN_B * D, 2 * D);
            EpiZsv E{Yb, Vb, (float*)(ws + WS_RSSP), AIN(I_SCCW) + (size_t)l * 3 * D, (LAS float*)(lds + 136192)};
            pg8::gemm_phase<EpiZsv, pg8::GridSched>(lds, 2 * D, S, E);
        }
#endif
        GRID_BAR();

#if PH(7)
        { PHASE_BEGIN;
            pg8::GridSched S; S.init(T / 256, D / 256, 8, G, bid, Yb, ws + WS_WSSD + l * WSSD_STRIDE, 2 * SSDI);
            { const float* rp = (const float*)(ws + WS_RSSP);
              for (int r = pm0 * 256 + bid * NTHR + tid; r < MR; r += G * NTHR) { const f32x4* p4 = (const f32x4*)(rp + (size_t)r * 80); float ss = 0.f;
#pragma unroll
                  for (int q = 0; q < 20; ++q) { const f32x4 v = p4[q]; ss += (v[0] + v[1]) + (v[2] + v[3]); }
                  RSS[r] = ss; } }
            EpiRowScale E{Y1b, nullptr};
            pg8::gemm_phase<EpiRowScale, pg8::GridSched>(lds, 2 * SSDI, S, E);
        }
        { PHASE_BEGIN;
            pg8::GridSched S; S.init(nMt, D / 256, pm0, G, G - 1 - bid, Vb, ws + WS_WSC + l * WSC_STRIDE, 2 * D);
            EpiRowScale E{Y2b, nullptr};
            pg8::gemm_phase<EpiRowScale, pg8::GridSched>(lds, 2 * D, S, E);
        }
        { PHASE_BEGIN;
            SplitKSched<4, 8, 8> S{G, lastl ? -(1 << 20) : bid, (const char*)Yb, (const char*)(ws + WS_WSSD + l * WSSD_STRIDE), (size_t)256 * 2 * SSDI};
            EpiPartialBf E{PY1};
            pg8::gemm_phase<EpiPartialBf, SplitKSched<4, 8, 8>, false, true>(lds, 2 * SSDI, S, E);
        }
#endif
        GRID_BAR();

#if PH(8)
        { PHASE_BEGIN;
            pg8::GridSched S; S.init(nMt, WIN_C_N / 256, pm0, G, bid, HB, WINT + (size_t)WIN_C * D, 2 * D);
            EpiGate E{MRG, Y1b, Y2b, AIN(I_BGATE) + l * 2 * D, RSS, lastl ? nullptr : PY1};
            pg8::gemm_phase<EpiGate, pg8::GridSched>(lds, 2 * D, S, E);
        }
#endif
        GRID_BAR();

#if PH(9)
        { PHASE_BEGIN;
            pg8::GridSched S; S.init(T / 256, D / 256, 8, G, bid, MRG, ws + WS_WO + l * WO_STRIDE, 2 * D);
            EpiRes E{XSRCL, XSRCC, OUT, CTXS, MODL, 2, 1.0f};
            pg8::gemm_phase<EpiRes, pg8::GridSched>(lds, 2 * D, S, E);
        }
        { PHASE_BEGIN;
            SplitKSched<4, 4, 4> S{G, lastl ? -(1 << 20) : bid, (const char*)MRG, (const char*)(ws + WS_WO + l * WO_STRIDE), (size_t)256 * 2 * D};
            EpiPartial E{DPART};
            pg8::gemm_phase<EpiPartial, SplitKSched<4, 4, 4>, false, true>(lds, 2 * D, S, E);
        }
#endif
        GRID_BAR();

        if (!lastl) {
#if PH(10)
            { PHASE_BEGIN;
                const float* g = AIN(I_N2G) + l * D;
                for (int r = gw; r < MR; r += NGW) {
                    const bool isc = r < TC; const int rr = isc ? r : r - TC; const int mrow = isc ? 8 : (rr >> 12);
                    const f32x4* xr = (const f32x4*)((isc ? XSRCC : (const float*)OUT) + (size_t)rr * D) + lane;
                    const float* mv = MODL + (size_t)mrow * (NMOD * D);
                    f32x4 v[4]; float ss = 0.f;
#pragma unroll
                    for (int j = 0; j < 4; ++j) v[j] = xr[64 * j];
                    if (isc) {
                        const f32x4* pp = (const f32x4*)(DPART + (size_t)rr * D) + lane; const f32x4* gt = (const f32x4*)(mv + 2 * D) + lane; f32x4* co = (f32x4*)(CTXS + (size_t)rr * D) + lane;
#pragma unroll
                        for (int j = 0; j < 4; ++j) { const f32x4 p = (pp[64 * j] + pp[(size_t)TC * D / 4 + 64 * j]) + (pp[(size_t)2 * TC * D / 4 + 64 * j] + pp[(size_t)3 * TC * D / 4 + 64 * j]); v[j] += gt[64 * j] * p; co[64 * j] = v[j]; } }
#pragma unroll
                    for (int j = 0; j < 4; ++j) ss += (v[j][0] * v[j][0] + v[j][1] * v[j][1]) + (v[j][2] * v[j][2] + v[j][3] * v[j][3]);
                    const float rstd = rsqrtf(wave_sum(ss) * (1.0f / D) + EPS);
#if FFN_F8 & 1
                    unsigned* o8 = (unsigned*)((unsigned char*)HB + (size_t)r * D) + lane;
#pragma unroll
                    for (int j = 0; j < 4; ++j) { const f32x4 gv = ((const f32x4*)g)[64 * j + lane], sh = ((const f32x4*)(mv + 3 * D))[64 * j + lane], scl = ((const f32x4*)(mv + 4 * D))[64 * j + lane];
                        const f32x4 y = v[j] * rstd * gv * (scl + 1.0f) + sh; o8[64 * j] = pk4_fp8(y[0], y[1], y[2], y[3]); }
#else
                    v2u* o8 = (v2u*)(HB + (size_t)r * D) + lane;
#pragma unroll
                    for (int j = 0; j < 4; ++j) { const f32x4 gv = ((const f32x4*)g)[64 * j + lane], sh = ((const f32x4*)(mv + 3 * D))[64 * j + lane], scl = ((const f32x4*)(mv + 4 * D))[64 * j + lane];
                        const f32x4 y = v[j] * rstd * gv * (scl + 1.0f) + sh; v2u w; w.x = cvt_pk_bf16(y[0], y[1]); w.y = cvt_pk_bf16(y[2], y[3]); o8[64 * j] = w; }
#endif
                }
            }
#endif
            GRID_BAR();
#if PH(11)
            { PHASE_BEGIN;
#if FFN_F8 == 3
                pg8::GridSched S; S.init(MR / 256, 2 * FFD / 256, 0, G, bid, HB, ws + WS_W13, D);
                EpiSwigluF8 E{(unsigned char*)HF, FFD, 0, 1.0f / MOE_WS1};
                pg8::gemm_phase<EpiSwigluF8, pg8::GridSched, true>(lds, D, S, E);
#elif FFN_F8 == 1
                pg8::GridSched S; S.init(MR / 256, 2 * FFD / 256, 0, G, bid, HB, ws + WS_W13, D);
                EpiSwigluS E{HF, FFD, 0, 1.0f / MOE_WS1};
                pg8::gemm_phase<EpiSwigluS, pg8::GridSched, true>(lds, D, S, E);
#elif FFN_F8 == 2
                pg8::GridSched S; S.init(MR / 256, 2 * FFD / 256, 0, G, bid, HB, ws + WS_W13, 2 * D);
                EpiSwigluF8 E{(unsigned char*)HF, FFD, 0, 1.0f};
                pg8::gemm_phase<EpiSwigluF8, pg8::GridSched>(lds, 2 * D, S, E);
#else
                pg8::GridSched S; S.init(MR / 256, 2 * FFD / 256, 0, G, bid, HB, ws + WS_W13, 2 * D);
                EpiSwiglu E{HF, FFD, 0};
                pg8::gemm_phase<EpiSwiglu, pg8::GridSched>(lds, 2 * D, S, E);
#endif
            }
#endif
            GRID_BAR();
#if PH(12)
            { PHASE_BEGIN;
#if FFN_F8 & 2
                pg8::GridSched S; S.init(MR / 256, D / 256, 0, G, bid, HF, ws + WS_W2, FFD);
                EpiRes E{OUT, CTXS, OUT, CTXS, MODL, 5, 1.0f / MOE_WS2};
                pg8::gemm_phase<EpiRes, pg8::GridSched, true>(lds, FFD, S, E);
#else
                pg8::GridSched S; S.init(T / 256, D / 256, 8, G, bid, HF, ws + WS_W2, 2 * FFD);
                EpiRes E{OUT, CTXS, OUT, CTXS, MODL, 5, 1.0f};
                pg8::gemm_phase<EpiRes, pg8::GridSched>(lds, 2 * FFD, S, E);
#endif
            }
#if !(FFN_F8 & 2)
            { PHASE_BEGIN;
                SplitKSched<4, 12, 10> S{G, bid, (const char*)HF, (const char*)(ws + WS_W2), (size_t)256 * 2 * FFD};
                EpiPartial E{DPART};
                pg8::gemm_phase<EpiPartial, SplitKSched<4, 12, 10>, false, true>(lds, 2 * FFD, S, E);
            }
#endif
#endif
            GRID_BAR();
        } else {
#define TOPI    ((unsigned*)(ws + WS_TOPI))
#define TOPW    ((float*)(ws + WS_TOPW))
#define TOKPOS  ((int*)(ws + WS_TOKPOS))
#define ROWLIST ((int*)(ws + WS_ROWLIST))
#define GATEW   ((float*)(ws + WS_GATEW))
#define CNTWG   ((int*)(ws + WS_CNTWG))
#define MOEINFO ((int*)(ws + WS_MOEINFO))
#define RPW (T / G)
#if PH(13)
            { PHASE_BEGIN;
                LAS float* rwl = (LAS float*)lds;
                LAS int* hist = (LAS int*)(lds + 32768);
                for (int i = tid; i < D * NEXP; i += NTHR) rwl[i] = AIN(I_RW)[i];
                if (tid < NEXP) hist[tid] = 0;
                __syncthreads();
                const float* g = AIN(I_N2G) + l * D;
                for (int ri = wave; ri < RPW; ri += NWAVES) {
                    const int rr = bid * RPW + ri, mrow = rr >> 12;
                    const f32x4* xr = (const f32x4*)(OUT + (size_t)rr * D) + lane;
                    const float* mv = MODL + (size_t)mrow * (NMOD * D);
                    f32x4 v[4]; float ss = 0.f;
#pragma unroll
                    for (int j = 0; j < 4; ++j) { v[j] = xr[64 * j]; ss += (v[j][0] * v[j][0] + v[j][1] * v[j][1]) + (v[j][2] * v[j][2] + v[j][3] * v[j][3]); }
                    const float rstd = rsqrtf(wave_sum(ss) * (1.0f / D) + EPS);
                    unsigned* o8 = (unsigned*)(ws + WS_H8 + (size_t)rr * D) + lane;
                    float lg[8];
#pragma unroll
                    for (int e = 0; e < 8; ++e) lg[e] = 0.f;
#pragma unroll
                    for (int j = 0; j < 4; ++j) { const f32x4 gv = ((const f32x4*)g)[64 * j + lane], sh = ((const f32x4*)(mv + 3 * D))[64 * j + lane], scl = ((const f32x4*)(mv + 4 * D))[64 * j + lane];
                        const f32x4 y = v[j] * rstd * gv * (scl + 1.0f) + sh; o8[64 * j] = pk4_fp8(y[0], y[1], y[2], y[3]);
#pragma unroll
                        for (int q = 0; q < 4; ++q) { const LAS f32x4* rp = (const LAS f32x4*)(rwl + (256 * j + 4 * lane + q) * 8); const f32x4 r0 = rp[0], r1 = rp[1];
                            lg[0] += y[q] * r0[0]; lg[1] += y[q] * r0[1]; lg[2] += y[q] * r0[2]; lg[3] += y[q] * r0[3]; lg[4] += y[q] * r1[0]; lg[5] += y[q] * r1[1]; lg[6] += y[q] * r1[2]; lg[7] += y[q] * r1[3]; } }
#pragma unroll
                    for (int e = 0; e < 8; ++e) lg[e] = wave_sum(lg[e]);
                    int i1 = 0; float v1 = lg[0];
#pragma unroll
                    for (int e = 1; e < 8; ++e) if (lg[e] > v1) { v1 = lg[e]; i1 = e; }
                    int i2 = -1; float v2 = -3.4e38f;
#pragma unroll
                    for (int e = 0; e < 8; ++e) if (e != i1 && lg[e] > v2) { v2 = lg[e]; i2 = e; }
                    const float w1 = 1.0f / (1.0f + __expf(v2 - v1));
                    if (lane == 0) { TOPI[rr] = (unsigned)i1 | ((unsigned)i2 << 8); TOPW[2 * rr] = w1; TOPW[2 * rr + 1] = 1.0f - w1; __hip_atomic_fetch_add(&hist[i1], 1, __ATOMIC_RELAXED, __HIP_MEMORY_SCOPE_WORKGROUP); __hip_atomic_fetch_add(&hist[i2], 1, __ATOMIC_RELAXED, __HIP_MEMORY_SCOPE_WORKGROUP); }
                }
                __syncthreads();
                if (tid < NEXP) CNTWG[bid * NEXP + tid] = hist[tid];
                __syncthreads();
                { const float* m1b = AIN(I_M1); const float* m3b = AIN(I_M3); const float* m2b = AIN(I_M2); unsigned char* w13 = ws + WS_MW13; unsigned char* w2 = ws + WS_MW2;
                  const int tpw = (NEXP * 672 + G - 1) / G;
                  conv_tiles_f8([=](int t) __attribute__((always_inline)) -> TileDesc { TileDesc td;
                      const int e = t / 672, r = t % 672;
                      if (r < 448) { const int nt = r >> 3, kt = r & 7;
                          const unsigned long long a1 = (unsigned long long)m1b, a3 = (unsigned long long)m3b, as = a1 ^ ((a1 ^ a3) & (0ull - (unsigned long long)(nt & 1)));
                          td.src = (const float*)as + (size_t)e * D * FFE + (size_t)(128 * kt) * FFE + 128 * (nt >> 1); td.ld = FFE;
                          td.dst = w13 + (size_t)e * 2 * FFE * D + (size_t)(128 * nt) * D + 128 * kt; td.dk = D; td.sc = MOE_WS1; }
                      else { const int r2 = r - 448, nt = r2 / 28, kt = r2 % 28;
                          td.src = m2b + (size_t)e * FFE * D + (size_t)(128 * kt) * D + 128 * nt; td.ld = D;
                          td.dst = w2 + (size_t)e * D * FFE + (size_t)(128 * nt) * FFE + 128 * kt; td.dk = FFE; td.sc = MOE_WS2; }
                      return td; },
                      bid * tpw, (bid + 1) * tpw < NEXP * 672 ? (bid + 1) * tpw : NEXP * 672, lds, tid); }
            }
#endif
            GRID_BAR();
#if PH(14)
            { PHASE_BEGIN;
                LAS int* cw_ = (LAS int*)lds;
                LAS int* tot = (LAS int*)(lds + 16384);
                LAS int* pos_ = (LAS int*)(lds + 20480);
                for (int i = tid; i < G * NEXP; i += NTHR) cw_[i] = CNTWG[i];
                __syncthreads();
                if (tid < NEXP) { int s = 0, mine = 0; for (int w = 0; w < G; ++w) { if (w == bid) mine = s; s += cw_[w * NEXP + tid]; } tot[tid] = s; tot[16 + tid] = mine; }
                __syncthreads();
                if (tid == 0) { int bs = 0; for (int e = 0; e < NEXP; ++e) { tot[8 + e] = bs; bs += (tot[e] + 255) & ~255; } tot[24] = bs; }
                __syncthreads();
                if (wave == 0) {
                    int run[8];
#pragma unroll
                    for (int e = 0; e < 8; ++e) run[e] = tot[8 + e] + tot[16 + e];
                    for (int ch = 0; ch < RPW / 64; ++ch) {
                        const int rr = bid * RPW + 64 * ch + lane; const unsigned ti = TOPI[rr]; const int i1 = ti & 255, i2 = (ti >> 8) & 255;
                        int p1 = 0, p2 = 0;
                        const unsigned long long ltm = (1ull << lane) - 1ull;
#pragma unroll
                        for (int e = 0; e < 8; ++e) { const unsigned long long m1 = __ballot(i1 == e), m2 = __ballot(i2 == e);
                            if (i1 == e) p1 = run[e] + __popcll(m1 & ltm);
                            if (i2 == e) p2 = run[e] + __popcll(m1) + __popcll(m2 & ltm);
                            run[e] += __popcll(m1) + __popcll(m2); }
                        ROWLIST[p1] = rr; ROWLIST[p2] = rr; GATEW[p1] = TOPW[2 * rr]; GATEW[p2] = TOPW[2 * rr + 1]; TOKPOS[2 * rr] = p1; TOKPOS[2 * rr + 1] = p2;
                        pos_[2 * (64 * ch + lane)] = p1; pos_[2 * (64 * ch + lane) + 1] = p2;
                    }
                }
                __syncthreads();
                for (int k = wave; k < RPW; k += NWAVES) { const v4u a = ((const v4u*)(ws + WS_H8 + (size_t)(bid * RPW + k) * D))[lane]; const int p1 = pos_[2 * k], p2 = pos_[2 * k + 1];
                    ((v4u*)(ws + WS_AG + (size_t)p1 * D))[lane] = a; ((v4u*)(ws + WS_AG + (size_t)p2 * D))[lane] = a; }
                if (bid == 0) {
                    for (int e = 0; e < NEXP; ++e) { const int lo = tot[8 + e] + tot[e], hi = tot[8 + e] + ((tot[e] + 255) & ~255); for (int i = lo + tid; i < hi; i += NTHR) { ROWLIST[i] = 0; GATEW[i] = 0.f; }
                        for (int i = lo * 64 + tid; i < hi * 64; i += NTHR) ((v4u*)(ws + WS_AG))[i] = (v4u){0u, 0u, 0u, 0u}; }
                    const int ntl = tot[24] >> 8;
                    if (tid == 0) MOEINFO[0] = ntl;
                    for (int jt = tid; jt < ntl; jt += NTHR) { int e = 0;
#pragma unroll
                        for (int q = 1; q < 8; ++q) if (jt * 256 >= tot[8 + q]) e = q;
                        MOEINFO[16 + jt] = e; }
                }
                __syncthreads();
            }
#endif
            GRID_BAR();
#if PH(15)
            { PHASE_BEGIN;
                const int ntl = __builtin_amdgcn_readfirstlane(MOEINFO[0]);
                const int ng = (ntl + MOE_GT - 1) / MOE_GT;
                {
                    const int t0 = 0, ntg = ntl < MOE_GT ? ntl : MOE_GT; (void)ng;
                    {
                        MoeUpSched S{G, bid, t0, ntg, MOEINFO + 16, (const char*)(ws + WS_AG), (const char*)(ws + WS_MW13)};
                        EpiSwigluF8 E{ws + WS_HM, FFE, t0, 1.0f / MOE_WS1};
                        pg8::gemm_phase<EpiSwigluF8, MoeUpSched, true>(lds, D, S, E);
                    }
                    GRID_BAR();
                    {
                        MoeDownSched S{G, bid, t0, ntg, MOEINFO + 16, (const char*)(ws + WS_HM), (const char*)(ws + WS_MW2)};
                        EpiMoeDown E{(bf16*)(ws + WS_YM), GATEW, 1.0f / MOE_WS2};
                        pg8::gemm_phase<EpiMoeDown, MoeDownSched, true>(lds, FFE, S, E);
                    }
                    GRID_BAR();
                }
            }
#endif
#if PH(16)
            { PHASE_BEGIN;
                const bf16* YM = (const bf16*)(ws + WS_YM); const float* fg = AIN(I_FG);
                for (int rr = gw; rr < T; rr += NGW) {
                    const int mrow = rr >> 12; const float* gm = MODL + (size_t)mrow * (NMOD * D) + 5 * D;
                    const int p0 = TOKPOS[2 * rr], p1 = TOKPOS[2 * rr + 1];
                    f32x4* xr = (f32x4*)(OUT + (size_t)rr * D) + lane;
                    const v2u* y0 = (const v2u*)(YM + (size_t)p0 * D) + lane; const v2u* y1 = (const v2u*)(YM + (size_t)p1 * D) + lane;
                    f32x4 v[4]; float ss = 0.f;
#pragma unroll
                    for (int j = 0; j < 4; ++j) { const f32x4 x = xr[64 * j], gv = ((const f32x4*)gm)[64 * j + lane]; const v2u a = y0[64 * j], b = y1[64 * j];
                        f32x4 m; m[0] = bflo(a.x) + bflo(b.x); m[1] = bfhi(a.x) + bfhi(b.x); m[2] = bflo(a.y) + bflo(b.y); m[3] = bfhi(a.y) + bfhi(b.y);
                        v[j] = x + gv * m; ss += (v[j][0] * v[j][0] + v[j][1] * v[j][1]) + (v[j][2] * v[j][2] + v[j][3] * v[j][3]); }
                    const float rstd = rsqrtf(wave_sum(ss) * (1.0f / D) + EPS);
#pragma unroll
                    for (int j = 0; j < 4; ++j) xr[64 * j] = v[j] * rstd * ((const f32x4*)fg)[64 * j + lane];
                }
            }
#else
            for (long i = (long)bid0 * NTHR + tid0; i < (long)T * D; i += (long)G0 * NTHR) args.out[i] = 0.f;
#endif
        }
    }
}

extern "C" void kernel_launch(void* const* d_in, const int* in_sizes, int n_in, void* d_out, int out_size, void* d_ws, size_t ws_size, hipStream_t stream) {
    static int grid = 0;
    if (grid == 0) {
        if (n_in != 28 || in_sizes[0] != T * D || out_size != T * D || ws_size < WS_END) { fprintf(stderr, "kernel_launch: unexpected shapes / workspace (n_in %d, ws %zu < %zu); nothing launched\n", n_in, ws_size, (size_t)WS_END); grid = -1; return; }
        int dev = 0, cus = 0, per_cu = 0;
        if (hipGetDevice(&dev) != hipSuccess || hipDeviceGetAttribute(&cus, hipDeviceAttributeMultiprocessorCount, dev) != hipSuccess) { grid = -1; return; }
        if (hipFuncSetAttribute((const void*)mk_fwd, hipFuncAttributeMaxDynamicSharedMemorySize, LDS_BYTES) != hipSuccess) { fprintf(stderr, "kernel_launch: hipFuncSetAttribute failed\n"); grid = -1; return; }
        if (hipOccupancyMaxActiveBlocksPerMultiprocessor(&per_cu, (const void*)mk_fwd, NTHR, LDS_BYTES) != hipSuccess || per_cu < 1) { fprintf(stderr, "kernel_launch: occupancy query reports %d blocks per CU\n", per_cu); }
        (void)hipGetLastError();
        if (cus != 256) { fprintf(stderr, "kernel_launch: built for 256 CUs, device has %d; nothing launched\n", cus); grid = -1; return; }
        grid = cus;
    }
    if (grid < 0) return;
    if (hipMemsetAsync((char*)d_ws + WS_CTL, 0, CTL_ZERO_BYTES, stream) != hipSuccess) return;
    Args a{};
    for (int i = 0; i < 28; ++i) a.in[i] = (const float*)d_in[i];
    a.out = (float*)d_out; a.ws = (unsigned char*)d_ws;
    hipLaunchKernelGGL(mk_fwd, dim3(grid), dim3(NTHR), LDS_BYTES, stream, a);
}
```
